# Optimizing an MI355X kernel written in HIP

```python
import math
import jax, jax.numpy as jnp
from jax import lax
import numpy as np

D_MODEL = 1024
BATCH = 8
SEQ = 4096
DEPTH = 4

ATTN_WIDTH = D_MODEL // 2
SSM_WIDTH = D_MODEL - ATTN_WIDTH
HEAD_DIM = 64
N_Q_HEADS = ATTN_WIDTH // HEAD_DIM
N_KV_HEADS = 2
Q_PER_KV = N_Q_HEADS // N_KV_HEADS
KV_WIDTH = N_KV_HEADS * HEAD_DIM
WINDOW = 128
BLOCK = 128
SSM_GROUP = 16
N_SSM_GROUPS = SSM_WIDTH // SSM_GROUP
STATE = 64
D_FF = 4 * D_MODEL
IN_WIDTH = ATTN_WIDTH + 2 * KV_WIDTH + SSM_WIDTH
N_MOD = 6
EPS = 1e-6
NEG_INF = -1e30
DT_MIN = 1e-3
DT_MAX = 1e-1

kernel_name = "hymba_swa_s5_sqrelu_adaln"


def rmsnorm(x, g):
    xf = x.astype(jnp.float32)
    y = xf * lax.rsqrt(jnp.mean(xf * xf, axis=-1, keepdims=True) + EPS)
    return (y * g.astype(jnp.float32)).astype(x.dtype)


def alibi_slopes():
    s = 2.0 ** (-8.0 * np.arange(1, N_Q_HEADS + 1) / N_Q_HEADS)
    return jnp.asarray(s, dtype=jnp.float32).reshape(N_KV_HEADS, Q_PER_KV)


def sliding_window_attention(q, k, v, sinks):
    b, l = q.shape[0], q.shape[1]
    nb = l // BLOCK
    qb = q.reshape(b, nb, BLOCK, N_KV_HEADS, Q_PER_KV, HEAD_DIM)

    def band(t):
        t = t.reshape(b, l, N_KV_HEADS, HEAD_DIM)
        tp = jnp.pad(t, ((0, 0), (BLOCK, 0), (0, 0), (0, 0)))
        tb = tp.reshape(b, nb + 1, BLOCK, N_KV_HEADS, HEAD_DIM)
        return jnp.concatenate([tb[:, :-1], tb[:, 1:]], axis=2)

    kb, vb = band(k), band(v)
    scores = jnp.einsum('bnqhgd,bnshd->bnhgqs', qb, kb).astype(jnp.float32) * (HEAD_DIM ** -0.5)

    r = jnp.arange(BLOCK)[:, None]
    j = jnp.arange(2 * BLOCK)[None, :]
    diff = BLOCK + r - j
    key_pos = (jnp.arange(nb)[:, None, None] - 1) * BLOCK + j[None]
    valid = ((diff >= 0) & (diff < WINDOW))[None] & (key_pos >= 0)
    bias = -alibi_slopes()[:, :, None, None] * diff.astype(jnp.float32)
    scores = jnp.where(valid[None, :, None, None], scores + bias, NEG_INF)

    sink = jnp.broadcast_to(sinks.astype(jnp.float32).reshape(1, 1, N_KV_HEADS, Q_PER_KV, 1, 1),
                            scores.shape[:-1] + (1,))
    probs = jax.nn.softmax(jnp.concatenate([scores, sink], axis=-1), axis=-1)[..., :-1]
    out = jnp.einsum('bnhgqs,bnshd->bnqhgd', probs.astype(v.dtype), vb)
    return out.reshape(b, l, ATTN_WIDTH)


def s5_mixer(u, lam_re, lam_im, log_dt, b_re, b_im, c_re, c_im, d_skip, w_glu, b_glu):
    bsz, l = u.shape[0], u.shape[1]
    uf = u.astype(jnp.float32)
    ug = uf.reshape(bsz, l, N_SSM_GROUPS, SSM_GROUP)
    dt = jnp.exp(log_dt.astype(jnp.float32))[:, None]
    lr = lam_re.astype(jnp.float32)
    li = lam_im.astype(jnp.float32)
    mag = jnp.exp(lr * dt)
    ang = li * dt
    ab_r = mag * jnp.cos(ang)
    ab_i = mag * jnp.sin(ang)
    nr = ab_r - 1.0
    ni = ab_i
    den = lr * lr + li * li
    f_r = (nr * lr + ni * li) / den
    f_i = (ni * lr - nr * li) / den
    br = b_re.astype(jnp.float32)
    bi = b_im.astype(jnp.float32)
    bb_r = f_r[..., None] * br - f_i[..., None] * bi
    bb_i = f_r[..., None] * bi + f_i[..., None] * br
    bu_r = jnp.einsum('blgc,gpc->blgp', ug, bb_r)
    bu_i = jnp.einsum('blgc,gpc->blgp', ug, bb_i)
    a_r = jnp.broadcast_to(ab_r, bu_r.shape)
    a_i = jnp.broadcast_to(ab_i, bu_i.shape)

    def combine(e1, e2):
        a1r, a1i, b1r, b1i = e1
        a2r, a2i, b2r, b2i = e2
        return (a2r * a1r - a2i * a1i,
                a2r * a1i + a2i * a1r,
                a2r * b1r - a2i * b1i + b2r,
                a2r * b1i + a2i * b1r + b2i)

    _, _, h_r, h_i = lax.associative_scan(combine, (a_r, a_i, bu_r, bu_i), axis=1)
    y = (jnp.einsum('blgp,gcp->blgc', h_r, c_re.astype(jnp.float32))
         - jnp.einsum('blgp,gcp->blgc', h_i, c_im.astype(jnp.float32)))
    y = y.reshape(bsz, l, SSM_WIDTH) + d_skip.astype(jnp.float32) * uf
    z = jax.nn.gelu(y).astype(u.dtype)
    return z * jax.nn.sigmoid(z @ w_glu + b_glu)


def setup_inputs(seed: int = 0) -> dict:
    key = jax.random.key(seed)
    ks = jax.random.split(key, 32)
    f32 = jnp.float32

    def nrm(k, shape, scale):
        return jax.random.normal(k, shape, f32) * scale

    def gain(k, shape):
        return 1.0 + 0.05 * jax.random.normal(k, shape, f32)

    L, G, P, C = DEPTH, N_SSM_GROUPS, STATE, SSM_GROUP
    n_idx = jnp.arange(P, dtype=f32)[None, None, :]
    return {
        "x": nrm(ks[0], (BATCH, SEQ, D_MODEL), 1.0),
        "c": nrm(ks[1], (BATCH, D_MODEL), 1.0),
        "w_ada": nrm(ks[2], (L, D_MODEL, N_MOD * D_MODEL), 0.5 * D_MODEL ** -0.5),
        "b_ada": nrm(ks[3], (L, N_MOD * D_MODEL), 0.02),
        "pre_mix_g": gain(ks[4], (L, D_MODEL)),
        "w_in": nrm(ks[5], (L, D_MODEL, IN_WIDTH), D_MODEL ** -0.5),
        "attn_sinks": nrm(ks[6], (L, N_Q_HEADS), 0.5),
        "lam_re": -0.5 * jnp.exp(0.05 * jax.random.normal(ks[7], (L, G, P), f32)),
        "lam_im": math.pi * n_idx + 0.01 * jax.random.normal(ks[8], (L, G, P), f32),
        "log_dt": jax.random.uniform(ks[9], (L, G), f32, math.log(DT_MIN), math.log(DT_MAX)),
        "b_re": nrm(ks[10], (L, G, P, C), (2.0 * C) ** -0.5),
        "b_im": nrm(ks[11], (L, G, P, C), (2.0 * C) ** -0.5),
        "c_re": nrm(ks[12], (L, G, C, P), (2.0 * P) ** -0.5 * 4.0),
        "c_im": nrm(ks[13], (L, G, C, P), (2.0 * P) ** -0.5 * 4.0),
        "d_skip": nrm(ks[14], (L, SSM_WIDTH), 1.0),
        "w_glu": nrm(ks[15], (L, SSM_WIDTH, SSM_WIDTH), SSM_WIDTH ** -0.5),
        "b_glu": nrm(ks[16], (L, SSM_WIDTH), 0.02),
        "attn_out_g": gain(ks[17], (L, ATTN_WIDTH)),
        "ssm_out_g": gain(ks[18], (L, SSM_WIDTH)),
        "w_out": nrm(ks[19], (L, D_MODEL, D_MODEL), D_MODEL ** -0.5),
        "post_mix_g": gain(ks[20], (L, D_MODEL)),
        "pre_mlp_g": gain(ks[21], (L, D_MODEL)),
        "w_mlp_in": nrm(ks[22], (L, D_MODEL, D_FF), D_MODEL ** -0.5),
        "w_mlp_out": nrm(ks[23], (L, D_FF, D_MODEL), D_FF ** -0.5),
        "post_mlp_g": gain(ks[24], (L, D_MODEL)),
    }


def reference(x, c, w_ada, b_ada, pre_mix_g, w_in, attn_sinks, lam_re, lam_im, log_dt,
              b_re, b_im, c_re, c_im, d_skip, w_glu, b_glu, attn_out_g, ssm_out_g, w_out,
              post_mix_g, pre_mlp_g, w_mlp_in, w_mlp_out, post_mlp_g):
    c_act = jax.nn.silu(c)
    split_pts = [ATTN_WIDTH, ATTN_WIDTH + KV_WIDTH, ATTN_WIDTH + 2 * KV_WIDTH]
    for i in range(DEPTH):
        mod = c_act @ w_ada[i] + b_ada[i]
        sh1, sc1, g1, sh2, sc2, g2 = [m[:, None, :] for m in jnp.split(mod, N_MOD, axis=-1)]

        h = rmsnorm(x, pre_mix_g[i]) * (1.0 + sc1) + sh1
        proj = h @ w_in[i]
        q, k, v, u = jnp.split(proj, split_pts, axis=-1)
        attn = sliding_window_attention(q, k, v, attn_sinks[i])
        ssm = s5_mixer(u, lam_re[i], lam_im[i], log_dt[i], b_re[i], b_im[i], c_re[i], c_im[i],
                       d_skip[i], w_glu[i], b_glu[i])
        heads = jnp.concatenate([rmsnorm(attn, attn_out_g[i]), rmsnorm(ssm, ssm_out_g[i])], axis=-1)
        mixed = heads @ w_out[i]
        x = x + g1 * rmsnorm(mixed, post_mix_g[i])

        h = rmsnorm(x, pre_mlp_g[i]) * (1.0 + sc2) + sh2
        f = jnp.square(jax.nn.relu(h @ w_mlp_in[i])) @ w_mlp_out[i]
        x = x + g2 * rmsnorm(f, post_mlp_g[i])
    return x
```

```cpp
#include <hip/hip_runtime.h>
#include <hip/hip_cooperative_groups.h>
#include <cstdio>
#include <cstdint>
namespace cg = cooperative_groups;

#ifndef MK_MULTI
#define MK_MULTI 1
#endif

#define GAS __attribute__((address_space(1)))
#define LAS __attribute__((address_space(3)))
typedef unsigned short bf16_t;
typedef short bf16x8 __attribute__((ext_vector_type(8)));
typedef short s16x4 __attribute__((ext_vector_type(4)));
typedef float f32x4 __attribute__((ext_vector_type(4)));
typedef float f32x2 __attribute__((ext_vector_type(2)));
typedef float f32x16 __attribute__((ext_vector_type(16)));
typedef unsigned u32x4 __attribute__((ext_vector_type(4)));
typedef unsigned u32x2 __attribute__((ext_vector_type(2)));

constexpr int D = 1024, NB = 8, SEQ = 4096, DEPTH = 4, M = NB * SEQ;
constexpr int AW = 512, SW = 512, NQH = 8, FF = 4096, INW = 1280, NMODC = 6 * D;
constexpr int NGRP = 32, NST = 64, NCH = 16;
constexpr float EPS = 1e-6f;
constexpr float LOG2E = 1.4426950408889634f;

constexpr size_t MiB = 1u << 20;
constexpr size_t WS_CTL = 0, CTL_ZERO_BYTES = 64 * 1024;
constexpr size_t WS_MOD = 1 * MiB;
constexpr size_t WS_WIN = 2 * MiB;
constexpr size_t WS_WOUT = 12 * MiB;
constexpr size_t WS_WGLU = 20 * MiB;
constexpr size_t WS_WMI = 22 * MiB;
constexpr size_t WS_WMO = 54 * MiB;
constexpr size_t WS_XN = 88 * MiB;
constexpr size_t WS_FM = 152 * MiB;
constexpr size_t WS_H = 216 * MiB;
constexpr size_t WS_PROJ = 216 * MiB;
constexpr size_t WS_HEADS = 296 * MiB;
constexpr size_t WS_Z = 360 * MiB;
constexpr size_t WS_END = 472 * MiB;
constexpr int CW_BAR = 1024;

constexpr int LDS_BYTES = 153600;
constexpr int MISC_OFF = LDS_BYTES - 256;

__device__ __forceinline__ unsigned cvt_pk_bf16(float lo, float hi) { unsigned r; asm volatile("v_cvt_pk_bf16_f32 %0, %1, %2" : "=v"(r) : "v"(lo), "v"(hi)); return r; }
__device__ __forceinline__ float bf_lo(unsigned w) { return __uint_as_float(w << 16); }
__device__ __forceinline__ float bf_hi(unsigned w) { return __uint_as_float(w & 0xffff0000u); }
__device__ __forceinline__ float bf2f(bf16_t v) { return __uint_as_float(((unsigned)v) << 16); }
__device__ __forceinline__ float wave_sum(float v) {
#pragma unroll
    for (int o = 1; o < 64; o <<= 1) v += __shfl_xor(v, o);
    return v;
}
__device__ __forceinline__ float fast_exp2(float x) { return __builtin_amdgcn_exp2f(x); }
__device__ __forceinline__ float sigmoidf_(float v) { return __builtin_amdgcn_rcpf(1.0f + fast_exp2(-LOG2E * v)); }
#define LDS_WAIT() asm volatile("s_waitcnt lgkmcnt(0)" ::: "memory")

namespace pg8 {
constexpr int BM = 256, BK = 64, HALF = 128, HTB = HALF * BK * 2, STAGE_BYTES = 8 * HTB, NXCD = 8, WGM = 8;
__host__ __device__ __forceinline__ int lds_byte(int r, int c) { const int st = (r >> 4) * 2 + (c >> 5), rr = r & 15, cc = c & 31, ob = rr * 64 + cc * 2; return st * 1024 + (ob ^ (((ob >> 9) & 1) << 5)); }
__host__ __device__ __forceinline__ void stage_rc(int b, int& R, int& C) { const int st = b / 1024, sb = b % 1024, swz = sb ^ (((sb >> 9) & 1) << 5); R = (st >> 1) * 16 + swz / 64; C = (st & 1) * 32 + (swz % 64) / 2; }
__host__ __device__ __forceinline__ int perm32(int rho) { const int n = rho >> 4, i = rho & 15; return 8 * (i >> 2) + 4 * n + (i & 3); }

struct Unit { int pm, pn; };
struct Gemm { const bf16_t* A; const bf16_t* Bt; int M, N, K; };

struct StaticOrder {
    int nM, nN, nwg, G, c;
    __host__ __device__ void init(int M_, int N_, int G_, int c_) { nM = M_ / BM; nN = N_ / BM; nwg = nM * nN; G = G_; c = c_; }
    __host__ __device__ bool next(int i, Unit& u) const {
        const long L = (long)i * G + c; if (L >= nwg) return false;
        int wgid = (int)L; { const int q = nwg / NXCD, r = nwg % NXCD, xcd = wgid % NXCD, off = wgid / NXCD; wgid = (xcd < r ? xcd * (q + 1) : r * (q + 1) + (xcd - r) * q) + off; }
        const int nig = WGM * nN, gid = wgid / nig, fm = gid * WGM, gsz = (nM - fm) < WGM ? (nM - fm) : WGM;
        u.pm = fm + ((wgid % nig) % gsz); u.pn = (wgid % nig) / gsz; return true;
    }
    __device__ __forceinline__ void a_ready(const Unit&) const {}
    __device__ __forceinline__ void done(const Unit&) const {}
};

struct EpiGen {
    static constexpr bool PERM = true, AFTER_DRAIN = false;
    bf16_t* O; int ldc; int mode; const bf16_t* Z; const float* bias;
    __device__ __forceinline__ void operator()(const f32x4 (&acc)[2][2][4][2], const Unit& u, int wr, int wc, int fr, int fq) const {
        const int row0 = u.pm * BM + wr * 64 + fr; const int col0 = u.pn * BM + wc * 32 + 8 * fq;
#pragma unroll
        for (int ai = 0; ai < 2; ++ai)
#pragma unroll
            for (int m = 0; m < 4; ++m) {
                const size_t row = (size_t)(row0 + ai * HALF + m * 16);
#pragma unroll
                for (int bj = 0; bj < 2; ++bj) {
                    const int col = col0 + bj * HALF;
                    f32x4 v0 = acc[ai][bj][m][0], v1 = acc[ai][bj][m][1];
                    if (mode == 1) {
#pragma unroll
                        for (int j = 0; j < 4; ++j) { const float a = fmaxf(v0[j], 0.f), b = fmaxf(v1[j], 0.f); v0[j] = a * a; v1[j] = b * b; }
                    } else if (mode == 2) {
                        const u32x4 zz = *(const u32x4*)(Z + row * 512 + col);
                        const f32x4 b0 = *(const f32x4*)(bias + col), b1 = *(const f32x4*)(bias + col + 4);
                        v0[0] = bf_lo(zz.x) * sigmoidf_(v0[0] + b0[0]); v0[1] = bf_hi(zz.x) * sigmoidf_(v0[1] + b0[1]);
                        v0[2] = bf_lo(zz.y) * sigmoidf_(v0[2] + b0[2]); v0[3] = bf_hi(zz.y) * sigmoidf_(v0[3] + b0[3]);
                        v1[0] = bf_lo(zz.z) * sigmoidf_(v1[0] + b1[0]); v1[1] = bf_hi(zz.z) * sigmoidf_(v1[1] + b1[1]);
                        v1[2] = bf_lo(zz.w) * sigmoidf_(v1[2] + b1[2]); v1[3] = bf_hi(zz.w) * sigmoidf_(v1[3] + b1[3]);
                    }
                    u32x4 w; w.x = cvt_pk_bf16(v0[0], v0[1]); w.y = cvt_pk_bf16(v0[2], v0[3]); w.z = cvt_pk_bf16(v1[0], v1[1]); w.w = cvt_pk_bf16(v1[2], v1[3]);
                    *(u32x4*)(O + row * ldc + col) = w;
                }
            }
    }
};

template <class Epi, class Sched, bool ALIGN_EPI = false, bool SP2 = false>
__device__ __forceinline__ void gemm_phase(LAS unsigned char* lds, const Gemm g, const Sched& S, const Epi& E, const int tid) {
    const int wid = __builtin_amdgcn_readfirstlane(tid >> 6), lane = tid & 63, wr = wid >> 2, wc = wid & 3, fr = lane & 15, fq = lane >> 4;
    const int K = g.K, nt = K / BK;
    unsigned voffA[2], voffB[2];
#pragma unroll
    for (int i = 0; i < 2; ++i) { int R, C; stage_rc(tid * 16 + i * 8192, R, C); const int Rb = Epi::PERM ? ((R & ~31) + perm32(R & 31)) : R;
        voffA[i] = (unsigned)(R * K + C) * 2u; voffB[i] = (unsigned)(Rb * K + C) * 2u; }
    const size_t kstep = (size_t)(BK * 2);
    const size_t hstep = (size_t)HALF * K * 2;
    const size_t tstep = 2 * hstep;
    const unsigned ldsw = (unsigned)wid * 1024u;
    const int aoff = lds_byte(wr * 64 + fr, fq * 8), boff = lds_byte(wc * 32 + fr, fq * 8);
#define PG8_SA(b, h) (((b) * 2 + (h)) * HTB)
#define PG8_SB(b, h) ((4 + (b) * 2 + (h)) * HTB)
#define PG8_STAGE(bufoff, gbase, voff) do { _Pragma("unroll") for (int _i = 0; _i < 2; ++_i) \
        __builtin_amdgcn_global_load_lds((const unsigned*)((const char*)(gbase) + (voff)[_i]), (LAS unsigned*)(lds + (bufoff) + ldsw + _i * 8192), 16, 0, 0); } while (0)
#define PG8_LDA(dst, b, h) do { _Pragma("unroll") for (int m = 0; m < 4; ++m) _Pragma("unroll") for (int k = 0; k < 2; ++k) dst[m][k] = *(const LAS bf16x8*)(lds + PG8_SA(b, h) + aoff + m * 2048 + k * 1024); } while (0)
#define PG8_LDB(dst, b, h) do { _Pragma("unroll") for (int n = 0; n < 2; ++n) _Pragma("unroll") for (int k = 0; k < 2; ++k) dst[n][k] = *(const LAS bf16x8*)(lds + PG8_SB(b, h) + boff + n * 2048 + k * 1024); } while (0)
#define PG8_MMA(ai, bj, At, Bt) do { __builtin_amdgcn_s_setprio(1); _Pragma("unroll") for (int m = 0; m < 4; ++m) _Pragma("unroll") for (int n = 0; n < 2; ++n) _Pragma("unroll") for (int k = 0; k < 2; ++k) \
        acc[ai][bj][m][n] = __builtin_amdgcn_mfma_f32_16x16x32_bf16(Bt[n][k], At[m][k], acc[ai][bj][m][n], 0, 0, 0); __builtin_amdgcn_s_setprio(0); } while (0)
#define PG8_WAIT_V(n) asm volatile("s_waitcnt vmcnt(" #n ")" ::: "memory")
#define PG8_WAIT_L(n) asm volatile("s_waitcnt lgkmcnt(" #n ")" ::: "memory")
#define PG8_BAR __builtin_amdgcn_s_barrier()
#define PG8_SCHED __builtin_amdgcn_sched_barrier(0)
    Unit cur, nxt; int ui = 0;
    if (!S.next(0, cur)) return;
    f32x4 acc[2][2][4][2];
#pragma unroll
    for (int a = 0; a < 2; ++a)
#pragma unroll
        for (int b = 0; b < 2; ++b)
#pragma unroll
            for (int m = 0; m < 4; ++m)
#pragma unroll
                for (int n = 0; n < 2; ++n) acc[a][b][m][n] = (f32x4){0.f, 0.f, 0.f, 0.f};
    bf16x8 At[4][2], B0[2][2], B1[2][2];
    const char* cA = (const char*)g.A + (size_t)cur.pm * tstep; const char* cB = (const char*)g.Bt + (size_t)cur.pn * tstep;
    S.a_ready(cur);
    if constexpr (SP2) {
        PG8_STAGE(PG8_SB(0, 0), cB, voffB); PG8_STAGE(PG8_SB(0, 1), cB + hstep, voffB); PG8_STAGE(PG8_SA(0, 0), cA, voffA); PG8_STAGE(PG8_SA(0, 1), cA + hstep, voffA);
        if (wr == 1) PG8_BAR;
        PG8_WAIT_V(2); PG8_BAR;
        PG8_STAGE(PG8_SB(1, 0), cB + kstep, voffB); PG8_STAGE(PG8_SA(1, 0), cA + kstep, voffA); PG8_STAGE(PG8_SB(1, 1), cB + hstep + kstep, voffB);
        PG8_WAIT_V(6); PG8_BAR;
    } else {
        PG8_STAGE(PG8_SB(0, 0), cB, voffB); PG8_STAGE(PG8_SA(0, 0), cA, voffA); PG8_STAGE(PG8_SB(0, 1), cB + hstep, voffB); PG8_STAGE(PG8_SA(0, 1), cA + hstep, voffA);
        if (wr == 1) PG8_BAR;
        PG8_WAIT_V(4); PG8_BAR;
        PG8_STAGE(PG8_SB(1, 0), cB + kstep, voffB); PG8_STAGE(PG8_SA(1, 0), cA + kstep, voffA); PG8_STAGE(PG8_SB(1, 1), cB + hstep + kstep, voffB);
        PG8_WAIT_V(6); PG8_BAR;
    }
    for (;;) {
        const bool has_next = S.next(ui + 1, nxt);
        const char* nA = has_next ? (const char*)g.A + (size_t)nxt.pm * tstep : cA; const char* nB = has_next ? (const char*)g.Bt + (size_t)nxt.pn * tstep : cB;
        for (int t = 0; t < nt; t += 2) {
            const bool last = (t == nt - 2);
            const char* a1 = cA + (size_t)(t + 1) * kstep;
            const char* a2 = last ? nA : cA + (size_t)(t + 2) * kstep; const char* b2 = last ? nB : cB + (size_t)(t + 2) * kstep;
            const char* a3 = a2 + kstep; const char* b3 = b2 + kstep;
            if (last && has_next) S.a_ready(nxt);
            if constexpr (SP2) {
            PG8_LDB(B0, 0, 0); PG8_LDB(B1, 0, 1); PG8_SCHED; PG8_LDA(At, 0, 0); PG8_STAGE(PG8_SA(1, 1), a1 + hstep, voffA);
            PG8_WAIT_V(8); PG8_WAIT_L(0); PG8_BAR; PG8_MMA(0, 0, At, B0); PG8_MMA(0, 1, At, B1); PG8_BAR; PG8_SCHED;
            PG8_LDA(At, 0, 1); PG8_STAGE(PG8_SB(0, 0), b2, voffB); PG8_STAGE(PG8_SB(0, 1), b2 + hstep, voffB); PG8_STAGE(PG8_SA(0, 0), a2, voffA);
            PG8_WAIT_V(8); PG8_WAIT_L(0); PG8_BAR; PG8_MMA(1, 0, At, B0); PG8_MMA(1, 1, At, B1); PG8_BAR; PG8_SCHED;
            PG8_LDB(B0, 1, 0); PG8_LDB(B1, 1, 1); PG8_SCHED; PG8_LDA(At, 1, 0); PG8_STAGE(PG8_SA(0, 1), a2 + hstep, voffA);
            PG8_WAIT_V(8); PG8_WAIT_L(0); PG8_BAR; PG8_MMA(0, 0, At, B0); PG8_MMA(0, 1, At, B1); PG8_BAR; PG8_SCHED;
            PG8_LDA(At, 1, 1); PG8_STAGE(PG8_SB(1, 0), b3, voffB); PG8_STAGE(PG8_SB(1, 1), b3 + hstep, voffB); PG8_STAGE(PG8_SA(1, 0), a3, voffA);
            PG8_WAIT_V(8); PG8_WAIT_L(0); PG8_BAR; PG8_MMA(1, 0, At, B0); PG8_MMA(1, 1, At, B1); PG8_BAR; PG8_SCHED;
            } else {
            PG8_LDB(B0, 0, 0); PG8_SCHED; PG8_LDA(At, 0, 0); PG8_STAGE(PG8_SA(1, 1), a1 + hstep, voffA);
            PG8_WAIT_L(8); PG8_BAR; PG8_WAIT_L(0); PG8_MMA(0, 0, At, B0); PG8_BAR; PG8_SCHED;
            PG8_LDB(B1, 0, 1); PG8_STAGE(PG8_SB(0, 0), b2, voffB);
            PG8_BAR; PG8_WAIT_L(0); PG8_MMA(0, 1, At, B1); PG8_BAR;
            PG8_LDA(At, 0, 1); PG8_STAGE(PG8_SA(0, 0), a2, voffA);
            PG8_BAR; PG8_WAIT_L(0); PG8_MMA(1, 0, At, B0); PG8_BAR; PG8_SCHED;
            PG8_STAGE(PG8_SB(0, 1), b2 + hstep, voffB);
            PG8_WAIT_V(6); PG8_BAR; PG8_MMA(1, 1, At, B1); PG8_BAR;
            PG8_LDB(B0, 1, 0); PG8_SCHED; PG8_LDA(At, 1, 0); PG8_STAGE(PG8_SA(0, 1), a2 + hstep, voffA);
            PG8_WAIT_L(8); PG8_BAR; PG8_WAIT_L(0); PG8_MMA(0, 0, At, B0); PG8_BAR; PG8_SCHED;
            PG8_LDB(B1, 1, 1); PG8_STAGE(PG8_SB(1, 0), b3, voffB);
            PG8_BAR; PG8_WAIT_L(0); PG8_MMA(0, 1, At, B1); PG8_BAR;
            PG8_LDA(At, 1, 1); PG8_STAGE(PG8_SA(1, 0), a3, voffA);
            PG8_BAR; PG8_WAIT_L(0); PG8_MMA(1, 0, At, B0); PG8_BAR; PG8_SCHED;
            PG8_STAGE(PG8_SB(1, 1), b3 + hstep, voffB);
            PG8_WAIT_V(6); PG8_BAR; PG8_MMA(1, 1, At, B1); PG8_BAR;
            }
        }
        if constexpr (ALIGN_EPI) { if (wr == 0) PG8_BAR; }
        if constexpr (!Epi::AFTER_DRAIN) { E(acc, cur, wr, wc, fr, fq); S.done(cur); }
        if (!has_next) break;
#pragma unroll
        for (int a = 0; a < 2; ++a)
#pragma unroll
            for (int b = 0; b < 2; ++b)
#pragma unroll
                for (int m = 0; m < 4; ++m)
#pragma unroll
                    for (int n = 0; n < 2; ++n) acc[a][b][m][n] = (f32x4){0.f, 0.f, 0.f, 0.f};
        cur = nxt; cA = nA; cB = nB; ++ui;
        if constexpr (ALIGN_EPI) { if (wr == 1) PG8_BAR; }
    }
    PG8_WAIT_V(0);
    if constexpr (!ALIGN_EPI) { if (wr == 0) PG8_BAR; }
    PG8_BAR;
#undef PG8_SA
#undef PG8_SB
#undef PG8_STAGE
#undef PG8_LDA
#undef PG8_LDB
#undef PG8_MMA
#undef PG8_WAIT_V
#undef PG8_WAIT_L
#undef PG8_BAR
#undef PG8_SCHED
}
}

__device__ __forceinline__ void gemm_call(LAS unsigned char* lds, const bf16_t* A, const bf16_t* Bt, int N, int K, const pg8::EpiGen& E, int tid) {
#if !defined(NO_GEMM)
    pg8::Gemm g{A, Bt, M, N, K};
    pg8::StaticOrder S; S.init(M, N, (int)gridDim.x, (int)blockIdx.x);
    pg8::gemm_phase<pg8::EpiGen, pg8::StaticOrder, true, true>(lds, g, S, E, tid);
#endif
}

#define XB_TMO      128
#define XB_XCNT(j)  (256  + 64 * (j))
#define XB_XSUB(j)  (1280 + 64 * (j))
#define XB_XGEN(j)  (2304 + 64 * (j))
#define XB_TOP      3328
#define XB_TOPGEN   3392
#define XCD_BAR_WORDS 3456
#define XB_SPIN_CAP (1u << 20)
__device__ __forceinline__ unsigned xb_ld(unsigned* p)              { return __hip_atomic_load(p, __ATOMIC_RELAXED, __HIP_MEMORY_SCOPE_AGENT); }
__device__ __forceinline__ unsigned xb_add(unsigned* p, unsigned v) { return __hip_atomic_fetch_add(p, v, __ATOMIC_RELAXED, __HIP_MEMORY_SCOPE_AGENT); }
__device__ __forceinline__ unsigned xb_xcc_id() { return (unsigned)__builtin_amdgcn_s_getreg((3 << 11) | 20) & 0xFu; }
#define XB_SPIN(cond, bar) do { unsigned _sp = 0; while (cond) { __builtin_amdgcn_s_sleep(1); \
    if ((++_sp & 255u) == 0u) { if (xb_ld(&(bar)[XB_TMO])) break; if (_sp > XB_SPIN_CAP) { atomicAdd(&(bar)[XB_TMO], 1u); break; } } } } while (0)
struct XcdBarrier { unsigned* bar; unsigned x; volatile LAS unsigned* st; };
__device__ __forceinline__ XcdBarrier xcd_barrier_post(unsigned* bar, volatile LAS unsigned* st) {
    XcdBarrier b; b.bar = bar; b.x = xb_xcc_id(); b.st = st;
    if (threadIdx.x == 0) (void)xb_add(&bar[XB_XCNT(b.x)], 1u);
    return b;
}
__device__ __forceinline__ void xcd_barrier_complete(unsigned* bar, unsigned x, unsigned& nloc, unsigned& nx) {
    const unsigned G = gridDim.x * gridDim.y * gridDim.z;
    unsigned sum, cnt, mine, sp = 0u;
    for (;;) {
        sum = 0u; cnt = 0u; mine = 0u;
#pragma unroll
        for (unsigned j = 0; j < 16; ++j) { const unsigned c = xb_ld(&bar[XB_XCNT(j)]); sum += c; cnt += (c > 0u) ? 1u : 0u; mine = (j == x) ? c : mine; }
        if (sum == G) break;
        __builtin_amdgcn_s_sleep(1);
        if ((++sp & 255u) == 0u) { if (xb_ld(&bar[XB_TMO])) break; if (sp > XB_SPIN_CAP) { atomicAdd(&bar[XB_TMO], 1u); break; } }
    }
    nloc = mine > 0u ? mine : 1u; nx = cnt > 0u ? cnt : 1u;
}
__device__ __forceinline__ void xcd_barrier(const XcdBarrier& b) {
    asm volatile("s_waitcnt vmcnt(0)" ::: "memory");
    __syncthreads();
    if (threadIdx.x == 0) {
        unsigned* bar = b.bar;
        __builtin_amdgcn_s_waitcnt(0);
        unsigned nloc = b.st[0], nx = b.st[1];
        if (nloc == 0u) { xcd_barrier_complete(bar, b.x, nloc, nx); b.st[0] = nloc; b.st[1] = nx; }
        const unsigned old = xb_add(&bar[XB_XSUB(b.x)], 1u);
        const unsigned gen = old / nloc;
        if (old + 1u == (gen + 1u) * nloc) {
            __builtin_amdgcn_fence(__ATOMIC_RELEASE, "agent");
            asm volatile("s_waitcnt vmcnt(0)" ::: "memory");
            const unsigned og = xb_add(&bar[XB_TOP], 1u);
            const unsigned tg = og / nx;
            if (og + 1u == (tg + 1u) * nx) xb_add(&bar[XB_TOPGEN], 1u);
            else XB_SPIN(xb_ld(&bar[XB_TOPGEN]) == tg, bar);
            __builtin_amdgcn_fence(__ATOMIC_ACQUIRE, "agent");
            xb_add(&bar[XB_XGEN(b.x)], 1u);
            asm volatile("s_waitcnt vmcnt(0)" ::: "memory");
        } else {
            XB_SPIN(xb_ld(&bar[XB_XGEN(b.x)]) == gen, bar);
            __builtin_amdgcn_fence(__ATOMIC_ACQUIRE, "agent");
            asm volatile("s_waitcnt vmcnt(0)" ::: "memory");
        }
    }
    __syncthreads();
}

struct Args {
    const float* in[25];
    float* out; unsigned char* ws;
    int ph_lo, ph_hi;
};
enum { I_X = 0, I_C, I_WADA, I_BADA, I_PREMIXG, I_WIN, I_SINKS, I_LAMRE, I_LAMIM, I_LOGDT, I_BRE, I_BIM, I_CRE, I_CIM, I_DSKIP, I_WGLU, I_BGLU,
       I_ATTNG, I_SSMG, I_WOUT, I_POSTMIXG, I_PREMLPG, I_WMI, I_WMO, I_POSTMLPG };

typedef const unsigned char __attribute__((address_space(4)))* kargp_t;
__device__ __forceinline__ const float* karg_in(int i) {
    kargp_t kp = (kargp_t)__builtin_amdgcn_kernarg_segment_ptr();
    asm volatile("" : "+s"(kp));
    return *(const float* const __attribute__((address_space(4)))*)(kp + 8 * i);
}
__device__ __forceinline__ float* karg_out() { kargp_t kp = (kargp_t)__builtin_amdgcn_kernarg_segment_ptr(); asm volatile("" : "+s"(kp)); return *(float* const __attribute__((address_space(4)))*)(kp + 8 * 25); }
__device__ __forceinline__ unsigned char* karg_ws() { kargp_t kp = (kargp_t)__builtin_amdgcn_kernarg_segment_ptr(); asm volatile("" : "+s"(kp)); return *(unsigned char* const __attribute__((address_space(4)))*)(kp + 8 * 26); }
__device__ __forceinline__ int karg_i(int i) { kargp_t kp = (kargp_t)__builtin_amdgcn_kernarg_segment_ptr(); asm volatile("" : "+s"(kp)); return *(const int __attribute__((address_space(4)))*)(kp + 8 * 27 + 4 * i); }
#define AIN(i) karg_in(i)
#define AWS() karg_ws()
#define AOUT() karg_out()

__device__ __forceinline__ void p0_transpose_item(const float* W, int K, int N, bf16_t* WT, const float* kscale, LAS float* scr, int item, int lane) {
    const int nblk = N / 32, kb = item / nblk, nb = item % nblk, k0 = 64 * kb, n0 = 32 * nb;
#pragma unroll 8
    for (int i = 0; i < 32; ++i) { const int kk = 2 * i + (lane >> 5); float v = W[(size_t)(k0 + kk) * N + n0 + (lane & 31)]; if (kscale) v *= kscale[k0 + kk]; scr[kk * 33 + (lane & 31)] = v; }
    LDS_WAIT(); asm volatile("" ::: "memory");
    const int c = lane & 7;
#pragma unroll
    for (int j = 0; j < 4; ++j) { const int n = (lane >> 3) + 8 * j; const LAS float* s = scr + (8 * c) * 33 + n;
        u32x4 o; o.x = cvt_pk_bf16(s[0 * 33], s[1 * 33]); o.y = cvt_pk_bf16(s[2 * 33], s[3 * 33]); o.z = cvt_pk_bf16(s[4 * 33], s[5 * 33]); o.w = cvt_pk_bf16(s[6 * 33], s[7 * 33]);
        *(u32x4*)(WT + (size_t)(n0 + n) * K + k0 + 8 * c) = o; }
    LDS_WAIT(); asm volatile("" ::: "memory");
}

__device__ __forceinline__ void phase_p0(LAS unsigned char* lds, int tid, int lane, int wave, int G) {
    LAS float* cact = (LAS float*)(lds + 67584);
    LAS float* red = (LAS float*)(lds + 100352);
    float* mod = (float*)(AWS() + WS_MOD);
    {
        const float* c = AIN(I_C);
        for (int e = tid; e < NB * D; e += 512) { const float v = c[e]; cact[e] = v / (1.0f + __expf(-v)); }
        __syncthreads();
        for (int item = blockIdx.x; item < DEPTH * (NMODC / 64); item += G) {
            const int l = item / (NMODC / 64), cb = item % (NMODC / 64), col = cb * 64 + lane;
            const float* w = AIN(I_WADA) + (size_t)l * D * NMODC + col;
            float acc[8];
#pragma unroll
            for (int b = 0; b < 8; ++b) acc[b] = 0.f;
            const int k0 = wave * 128;
#pragma unroll 4
            for (int k = k0; k < k0 + 128; ++k) {
                const float wv = w[(size_t)k * NMODC];
#pragma unroll
                for (int b = 0; b < 8; ++b) acc[b] += wv * cact[b * D + k];
            }
#pragma unroll
            for (int b = 0; b < 8; ++b) red[(wave * 8 + b) * 64 + lane] = acc[b];
            __syncthreads();
            {
                const int b = wave; float s = 0.f;
#pragma unroll
                for (int w8 = 0; w8 < 8; ++w8) s += red[(w8 * 8 + b) * 64 + lane];
                mod[((size_t)l * NB + b) * NMODC + col] = s + AIN(I_BADA)[(size_t)l * NMODC + col];
            }
            __syncthreads();
        }
    }
    LAS float* scr = (LAS float*)(lds + wave * 8448);
    const int gw = blockIdx.x * 8 + wave, NGW = G * 8;
    constexpr int I_IN = (D / 64) * (INW / 32), I_OUT = (D / 64) * (D / 32), I_GLU = (SW / 64) * (SW / 32), I_MI = (D / 64) * (FF / 32), I_MO = (FF / 64) * (D / 32);
    constexpr int PER_L = I_IN + I_OUT + I_GLU + I_MI + I_MO;
    for (int it = gw; it < DEPTH * PER_L; it += NGW) {
        const int l = it / PER_L; int r = it % PER_L;
        if (r < I_IN) { p0_transpose_item(AIN(I_WIN) + (size_t)l * D * INW, D, INW, (bf16_t*)(AWS() + WS_WIN) + (size_t)l * INW * D, nullptr, scr, r, lane); continue; } r -= I_IN;
        if (r < I_OUT) {
            const int kb = r / (D / 32); const float* ks = (kb * 64 < AW) ? (AIN(I_ATTNG) + (size_t)l * AW) : (AIN(I_SSMG) + (size_t)l * SW - AW);
            p0_transpose_item(AIN(I_WOUT) + (size_t)l * D * D, D, D, (bf16_t*)(AWS() + WS_WOUT) + (size_t)l * D * D, ks, scr, r, lane); continue; } r -= I_OUT;
        if (r < I_GLU) { p0_transpose_item(AIN(I_WGLU) + (size_t)l * SW * SW, SW, SW, (bf16_t*)(AWS() + WS_WGLU) + (size_t)l * SW * SW, nullptr, scr, r, lane); continue; } r -= I_GLU;
        if (r < I_MI) { p0_transpose_item(AIN(I_WMI) + (size_t)l * D * FF, D, FF, (bf16_t*)(AWS() + WS_WMI) + (size_t)l * FF * D, nullptr, scr, r, lane); continue; } r -= I_MI;
        p0_transpose_item(AIN(I_WMO) + (size_t)l * FF * D, FF, D, (bf16_t*)(AWS() + WS_WMO) + (size_t)l * D * FF, nullptr, scr, r, lane);
    }
}

__device__ __forceinline__ void thin_resid(const bf16_t* src, const float* xs, float* xd, const float* gate, const float* pg,
                                           const float* ng, const float* nsc, const float* nsh, bf16_t* xn, int gw, int NGW, int lane) {
    for (int m = gw; m < M; m += NGW) {
        const int b = m >> 12;
        f32x4 xv[4];
#pragma unroll
        for (int j = 0; j < 4; ++j) xv[j] = ((const f32x4*)(xs + (size_t)m * D))[lane + 64 * j];
        if (src) {
            f32x4 f[4]; float ss = 0.f;
#pragma unroll
            for (int j = 0; j < 4; ++j) { const u32x2 w = ((const u32x2*)(src + (size_t)m * D))[lane + 64 * j];
                f[j] = (f32x4){bf_lo(w.x), bf_hi(w.x), bf_lo(w.y), bf_hi(w.y)}; ss += (f[j].x * f[j].x + f[j].y * f[j].y) + (f[j].z * f[j].z + f[j].w * f[j].w); }
            const float rstd = rsqrtf(wave_sum(ss) * (1.0f / D) + EPS);
#pragma unroll
            for (int j = 0; j < 4; ++j) { const int col = 4 * (lane + 64 * j);
                const f32x4 gt = *(const f32x4*)(gate + (size_t)b * NMODC + col), pgv = *(const f32x4*)(pg + col);
                xv[j] += gt * pgv * (f[j] * rstd);
                ((f32x4*)(xd + (size_t)m * D))[lane + 64 * j] = xv[j]; }
        }
        if (xn) {
            float ss = 0.f;
#pragma unroll
            for (int j = 0; j < 4; ++j) ss += (xv[j].x * xv[j].x + xv[j].y * xv[j].y) + (xv[j].z * xv[j].z + xv[j].w * xv[j].w);
            const float rstd = rsqrtf(wave_sum(ss) * (1.0f / D) + EPS);
#pragma unroll
            for (int j = 0; j < 4; ++j) { const int col = 4 * (lane + 64 * j);
                const f32x4 g = *(const f32x4*)(ng + col), sc = *(const f32x4*)(nsc + (size_t)b * NMODC + col), sh = *(const f32x4*)(nsh + (size_t)b * NMODC + col);
                const f32x4 h = xv[j] * rstd * g * (1.0f + sc) + sh;
                u32x2 w; w.x = cvt_pk_bf16(h.x, h.y); w.y = cvt_pk_bf16(h.z, h.w);
                ((u32x2*)(xn + (size_t)m * D))[lane + 64 * j] = w; }
        }
    }
}
__device__ __forceinline__ void thin_ssm_norm(bf16_t* heads, int gw, int NGW, int lane) {
    for (int m = gw; m < M; m += NGW) {
        u32x4* p = (u32x4*)(heads + (size_t)m * D + AW) + lane;
        const u32x4 w = *p;
        float v[8] = {bf_lo(w.x), bf_hi(w.x), bf_lo(w.y), bf_hi(w.y), bf_lo(w.z), bf_hi(w.z), bf_lo(w.w), bf_hi(w.w)};
        float ss = 0.f;
#pragma unroll
        for (int i = 0; i < 8; ++i) ss += v[i] * v[i];
        const float rstd = rsqrtf(wave_sum(ss) * (1.0f / SW) + EPS);
        u32x4 o; o.x = cvt_pk_bf16(v[0] * rstd, v[1] * rstd); o.y = cvt_pk_bf16(v[2] * rstd, v[3] * rstd); o.z = cvt_pk_bf16(v[4] * rstd, v[5] * rstd); o.w = cvt_pk_bf16(v[6] * rstd, v[7] * rstd);
        *p = o;
    }
}

__device__ __forceinline__ int crow(int r, int hi) { return (r & 3) + 8 * (r >> 2) + 4 * hi; }
constexpr int KS_PITCH = 72, VT_PITCH = 260;
constexpr int ATT_VT_OFF = 2 * 256 * KS_PITCH * 2;
constexpr int ATT_SSQ_OFF = ATT_VT_OFF + 2 * 64 * VT_PITCH * 2;
__device__ __forceinline__ void attn_unit(LAS unsigned char* lds, const bf16_t* PROJ, bf16_t* HEADS, const float* sinks, int b, int n, int tid) {
    const int lane = tid & 63, wave = __builtin_amdgcn_readfirstlane(tid >> 6), r32 = lane & 31, hi = lane >> 5;
    LAS bf16_t* Ks = (LAS bf16_t*)lds;
    LAS bf16_t* VT = (LAS bf16_t*)(lds + ATT_VT_OFF);
    LAS float* SSQ = (LAS float*)(lds + ATT_SSQ_OFF);
    const long rowq0 = (long)b * SEQ + n * 128;
    const long rowk0 = rowq0 - 128;
#pragma unroll
    for (int i = 0; i < 8; ++i) {
        const int id = i * 512 + tid, key = id >> 4, rem = id & 15, kvh = rem >> 3, pc = rem & 7;
        u32x4 v = (u32x4){0u, 0u, 0u, 0u};
        if (n > 0 || key >= 128) v = *(const u32x4*)(PROJ + (size_t)(rowk0 + key) * INW + 512 + kvh * 64 + pc * 8);
        *(LAS u32x4*)(Ks + (kvh * 256 + key) * KS_PITCH + pc * 8) = v;
    }
    {
        const int kp = lane & 15, q = lane >> 4, key0 = wave * 32 + 2 * kp;
#pragma unroll
        for (int kvh = 0; kvh < 2; ++kvh)
#pragma unroll
            for (int ph = 0; ph < 2; ++ph) {
                const int pc = q + 4 * ph;
                u32x4 va = (u32x4){0u, 0u, 0u, 0u}, vc = (u32x4){0u, 0u, 0u, 0u};
                if (n > 0 || key0 >= 128) {
                    va = *(const u32x4*)(PROJ + (size_t)(rowk0 + key0) * INW + 640 + kvh * 64 + pc * 8);
                    vc = *(const u32x4*)(PROJ + (size_t)(rowk0 + key0 + 1) * INW + 640 + kvh * 64 + pc * 8);
                }
                LAS bf16_t* dst = VT + (kvh * 64 + pc * 8) * VT_PITCH + key0;
#pragma unroll
                for (int t = 0; t < 4; ++t) {
                    const unsigned wa = va[t], wc = vc[t];
                    *(LAS unsigned*)(dst + (2 * t) * VT_PITCH) = (wa & 0xffffu) | (wc << 16);
                    *(LAS unsigned*)(dst + (2 * t + 1) * VT_PITCH) = (wa >> 16) | (wc & 0xffff0000u);
                }
            }
    }
    __syncthreads();
    const int h = wave, kvh = h >> 2;
    const float slope2 = exp2f(-(float)(h + 1)) * LOG2E;
    const float sink2 = sinks[h] * LOG2E;
    const float sc2 = 0.125f * LOG2E;
    for (int i = 0; i < 4; ++i) {
        bf16x8 qf[4];
#pragma unroll
        for (int dd = 0; dd < 4; ++dd) qf[dd] = *(const bf16x8*)(PROJ + (size_t)(rowq0 + 32 * i + r32) * INW + h * 64 + dd * 16 + hi * 8);
        f32x16 s[5];
#pragma unroll
        for (int kt = 0; kt < 5; ++kt) {
#pragma unroll
            for (int r = 0; r < 16; ++r) s[kt][r] = 0.f;
#pragma unroll
            for (int dd = 0; dd < 4; ++dd) {
                const bf16x8 kf = *(const LAS bf16x8*)(Ks + (kvh * 256 + 32 * (i + kt) + r32) * KS_PITCH + dd * 16 + hi * 8);
                s[kt] = __builtin_amdgcn_mfma_f32_32x32x16_bf16(kf, qf[dd], s[kt], 0, 0, 0);
            }
        }
        float mx = sink2;
        int r32v = r32; asm volatile("" : "+v"(r32v));
        const float fbase = (float)(128 + r32v - 4 * hi);
#pragma unroll
        for (int kt = 0; kt < 5; ++kt) {
            const bool tile_ok = (n > 0) || (i + kt >= 4);
#pragma unroll
            for (int r = 0; r < 16; ++r) {
                const int c0 = (r & 3) + 8 * (r >> 2);
                const float diff = fbase - (float)(32 * kt + c0);
                bool valid = tile_ok;
                if (kt == 0) valid = valid && (diff < 128.0f);
                if (kt == 4) valid = valid && (diff >= 0.0f);
                float v = s[kt][r] * sc2 - slope2 * diff;
                v = valid ? v : -1e30f;
                s[kt][r] = v; mx = fmaxf(mx, v);
            }
        }
        mx = fmaxf(mx, __shfl_xor(mx, 32));
        float lsum = 0.f;
#pragma unroll
        for (int kt = 0; kt < 5; ++kt)
#pragma unroll
            for (int r = 0; r < 16; ++r) { const float p = fast_exp2(s[kt][r] - mx); s[kt][r] = p; lsum += p; }
        lsum += __shfl_xor(lsum, 32);
        lsum += fast_exp2(sink2 - mx);
        const float linv = 1.0f / lsum;
        f32x16 o[2];
#pragma unroll
        for (int r = 0; r < 16; ++r) { o[0][r] = 0.f; o[1][r] = 0.f; }
#pragma unroll
        for (int kt = 0; kt < 5; ++kt)
#pragma unroll
            for (int kk = 0; kk < 2; ++kk) {
                u32x4 pw;
                pw.x = cvt_pk_bf16(s[kt][8 * kk + 0], s[kt][8 * kk + 1]); pw.y = cvt_pk_bf16(s[kt][8 * kk + 2], s[kt][8 * kk + 3]);
                pw.z = cvt_pk_bf16(s[kt][8 * kk + 4], s[kt][8 * kk + 5]); pw.w = cvt_pk_bf16(s[kt][8 * kk + 6], s[kt][8 * kk + 7]);
                const bf16x8 pa = __builtin_bit_cast(bf16x8, pw);
                const int kbase = 32 * (i + kt) + 16 * kk + 4 * hi;
#pragma unroll
                for (int dt = 0; dt < 2; ++dt) {
                    const LAS bf16_t* vp = VT + (kvh * 64 + 32 * dt + r32) * VT_PITCH + kbase;
                    const s16x4 lo = *(const LAS s16x4*)vp, hi4 = *(const LAS s16x4*)(vp + 8);
                    const bf16x8 vb = (bf16x8){lo[0], lo[1], lo[2], lo[3], hi4[0], hi4[1], hi4[2], hi4[3]};
                    o[dt] = __builtin_amdgcn_mfma_f32_32x32x16_bf16(pa, vb, o[dt], 0, 0, 0);
                }
            }
#pragma unroll
        for (int r = 0; r < 16; ++r) {
            const float li = __shfl(linv, crow(r, hi));
            o[0][r] *= li; o[1][r] *= li;
            float q = o[0][r] * o[0][r] + o[1][r] * o[1][r];
            q += __shfl_xor(q, 1); q += __shfl_xor(q, 2); q += __shfl_xor(q, 4); q += __shfl_xor(q, 8); q += __shfl_xor(q, 16);
            if (r32 == 0) SSQ[(32 * i + crow(r, hi)) * 8 + h] = q;
        }
        __syncthreads();
#pragma unroll
        for (int r = 0; r < 16; ++r) {
            const int qrow = 32 * i + crow(r, hi);
            const f32x4 a0 = *(const LAS f32x4*)(SSQ + qrow * 8), a1 = *(const LAS f32x4*)(SSQ + qrow * 8 + 4);
            const float tot = (a0.x + a0.y) + (a0.z + a0.w) + (a1.x + a1.y) + (a1.z + a1.w);
            const float rstd = rsqrtf(tot * (1.0f / AW) + EPS);
            bf16_t* op = HEADS + (size_t)(rowq0 + qrow) * D + h * 64 + r32;
            op[0] = (bf16_t)(cvt_pk_bf16(o[0][r] * rstd, 0.f) & 0xffffu);
            op[32] = (bf16_t)(cvt_pk_bf16(o[1][r] * rstd, 0.f) & 0xffffu);
        }
    }
    __syncthreads();
}

constexpr int SSM_WAVE_BYTES = 12800, BU_PITCH = 132, HS_PITCH = 136;
constexpr int SSM_BB_OFF = 8 * SSM_WAVE_BYTES, SSM_CM_OFF = SSM_BB_OFF + 4096, SSM_AB_OFF = SSM_CM_OFF + 16 * HS_PITCH * 2, SSM_SG_OFF = SSM_AB_OFF + 512;
struct SsmParams { const float *lam_re, *lam_im, *log_dt, *b_re, *b_im, *c_re, *c_im, *d_skip; };
__device__ __forceinline__ void ssm_unit(LAS unsigned char* lds, const bf16_t* PROJ, bf16_t* Z, const SsmParams& sp, int b, int g, int tid) {
    const int lane = tid & 63, wave = __builtin_amdgcn_readfirstlane(tid >> 6), fr = lane & 15, fq = lane >> 4;
    LAS float* BU = (LAS float*)(lds + wave * SSM_WAVE_BYTES);
    LAS bf16_t* HS = (LAS bf16_t*)(lds + wave * SSM_WAVE_BYTES + 8448);
    LAS bf16_t* BB = (LAS bf16_t*)(lds + SSM_BB_OFF);
    LAS bf16_t* CM = (LAS bf16_t*)(lds + SSM_CM_OFF);
    LAS float* AB = (LAS float*)(lds + SSM_AB_OFF);
    LAS float* SG = (LAS float*)(lds + SSM_SG_OFF);
    if (tid < 64) {
        const int p = tid;
        const float dt = expf(sp.log_dt[g]);
        const float lr = sp.lam_re[g * NST + p], li = sp.lam_im[g * NST + p];
        const float mag = expf(lr * dt), ang = li * dt;
        float sn, cs; sincosf(ang, &sn, &cs);
        const float abr = mag * cs, abi = mag * sn;
        const float nr = abr - 1.0f, ni = abi, den = lr * lr + li * li;
        const float f_r = (nr * lr + ni * li) / den, f_i = (ni * lr - nr * li) / den;
        AB[2 * p] = abr; AB[2 * p + 1] = abi;
        const float* br = sp.b_re + (size_t)(g * NST + p) * NCH; const float* bi = sp.b_im + (size_t)(g * NST + p) * NCH;
#pragma unroll
        for (int c = 0; c < NCH; c += 2) {
            const float r0 = f_r * br[c] - f_i * bi[c], i0 = f_r * bi[c] + f_i * br[c];
            const float r1 = f_r * br[c + 1] - f_i * bi[c + 1], i1 = f_r * bi[c + 1] + f_i * br[c + 1];
            *(LAS unsigned*)(BB + (2 * p) * NCH + c) = cvt_pk_bf16(r0, r1);
            *(LAS unsigned*)(BB + (2 * p + 1) * NCH + c) = cvt_pk_bf16(i0, i1);
        }
    }
    for (int e = tid; e < NCH * 128; e += 512) {
        const int c = e >> 7, k = e & 127, p = k >> 1;
        const float v = (k & 1) ? -sp.c_im[(size_t)(g * NCH + c) * NST + p] : sp.c_re[(size_t)(g * NCH + c) * NST + p];
        CM[c * HS_PITCH + k] = (bf16_t)(cvt_pk_bf16(v, 0.f) & 0xffffu);
    }
    __syncthreads();
    bf16x8 bbf[8], cmf[4];
#pragma unroll
    for (int t = 0; t < 8; ++t) { bbf[t] = (bf16x8){0, 0, 0, 0, 0, 0, 0, 0}; if (fq < 2) bbf[t] = *(const LAS bf16x8*)(BB + (16 * t + fr) * NCH + 8 * fq); }
#pragma unroll
    for (int s = 0; s < 4; ++s) cmf[s] = *(const LAS bf16x8*)(CM + fr * HS_PITCH + 32 * s + 8 * fq);
    const float dsk = sp.d_skip[g * NCH + fr];
    const float ar = AB[2 * lane], ai = AB[2 * lane + 1];
    const size_t row0 = (size_t)b * SEQ + wave * 512;
    const bf16_t* ubase = PROJ + row0 * INW + 768 + g * NCH;
    float hr = 0.f, hi_ = 0.f;
    for (int ch = 0; ch < 32; ++ch) {
        bf16x8 uf = (bf16x8){0, 0, 0, 0, 0, 0, 0, 0};
        if (fq < 2) uf = *(const bf16x8*)(ubase + (size_t)(ch * 16 + fr) * INW + 8 * fq);
#pragma unroll
        for (int t = 0; t < 8; ++t) {
            const f32x4 d = __builtin_amdgcn_mfma_f32_16x16x32_bf16(bbf[t], uf, (f32x4){0.f, 0.f, 0.f, 0.f}, 0, 0, 0);
            *(LAS f32x4*)(BU + fr * BU_PITCH + 16 * t + 4 * fq) = d;
        }
#pragma unroll
        for (int tau = 0; tau < 16; ++tau) {
            const f32x2 bu = *(const LAS f32x2*)(BU + tau * BU_PITCH + 2 * lane);
            const float nhr = ar * hr - ai * hi_ + bu.x, nhi = ar * hi_ + ai * hr + bu.y;
            hr = nhr; hi_ = nhi;
        }
    }
    SG[(wave * 64 + lane) * 2] = hr; SG[(wave * 64 + lane) * 2 + 1] = hi_;
    __syncthreads();
    {
        float pr = ar, pi = ai;
#pragma unroll
        for (int s = 0; s < 9; ++s) { const float nr = pr * pr - pi * pi, ni = 2.0f * pr * pi; pr = nr; pi = ni; }
        hr = 0.f; hi_ = 0.f;
        for (int w2 = 0; w2 < wave; ++w2) {
            const float sr = SG[(w2 * 64 + lane) * 2], si = SG[(w2 * 64 + lane) * 2 + 1];
            const float nhr = pr * hr - pi * hi_ + sr, nhi = pr * hi_ + pi * hr + si;
            hr = nhr; hi_ = nhi;
        }
    }
    for (int ch = 0; ch < 32; ++ch) {
        bf16x8 uf = (bf16x8){0, 0, 0, 0, 0, 0, 0, 0};
        if (fq < 2) uf = *(const bf16x8*)(ubase + (size_t)(ch * 16 + fr) * INW + 8 * fq);
        float uu[4];
#pragma unroll
        for (int r = 0; r < 4; ++r) uu[r] = bf2f(ubase[(size_t)(ch * 16 + 4 * fq + r) * INW + fr]);
#pragma unroll
        for (int t = 0; t < 8; ++t) {
            const f32x4 d = __builtin_amdgcn_mfma_f32_16x16x32_bf16(bbf[t], uf, (f32x4){0.f, 0.f, 0.f, 0.f}, 0, 0, 0);
            *(LAS f32x4*)(BU + fr * BU_PITCH + 16 * t + 4 * fq) = d;
        }
#pragma unroll
        for (int tau = 0; tau < 16; ++tau) {
            const f32x2 bu = *(const LAS f32x2*)(BU + tau * BU_PITCH + 2 * lane);
            const float nhr = ar * hr - ai * hi_ + bu.x, nhi = ar * hi_ + ai * hr + bu.y;
            hr = nhr; hi_ = nhi;
            *(LAS unsigned*)(HS + tau * HS_PITCH + 2 * lane) = cvt_pk_bf16(hr, hi_);
        }
        f32x4 y = (f32x4){0.f, 0.f, 0.f, 0.f};
#pragma unroll
        for (int s = 0; s < 4; ++s) {
            const bf16x8 hf = *(const LAS bf16x8*)(HS + fr * HS_PITCH + 32 * s + 8 * fq);
            y = __builtin_amdgcn_mfma_f32_16x16x32_bf16(hf, cmf[s], y, 0, 0, 0);
        }
#pragma unroll
        for (int r = 0; r < 4; ++r) {
            const float yy = y[r] + dsk * uu[r];
            const float inner = 0.7978845608028654f * (yy + 0.044715f * yy * yy * yy);
            const float zz = yy * __builtin_amdgcn_rcpf(1.0f + fast_exp2(-2.0f * LOG2E * inner));
            Z[(row0 + ch * 16 + 4 * fq + r) * SW + g * NCH + fr] = (bf16_t)(cvt_pk_bf16(zz, 0.f) & 0xffffu);
        }
    }
    __syncthreads();
}

constexpr int N_PHASES = 2 + 9 * DEPTH;
__global__ void __launch_bounds__(512, 2) fwd_kernel(Args a) {
    extern __shared__ __attribute__((aligned(16))) unsigned char lds_raw[];
    LAS unsigned char* lds = (LAS unsigned char*)lds_raw;
    const int G = gridDim.x;
    volatile LAS unsigned* MISC = (volatile LAS unsigned*)(lds + MISC_OFF);
    if (threadIdx.x < 64) MISC[threadIdx.x] = 0u;
    __syncthreads();
    unsigned* ctl = (unsigned*)(AWS() + WS_CTL);
    XcdBarrier bar; bar.bar = ctl + CW_BAR; bar.x = 0; bar.st = nullptr;
    const int ph_lo = karg_i(0), ph_hi = karg_i(1);
    const bool multi_phase = (ph_hi - ph_lo) > 1;
    if (multi_phase) bar = xcd_barrier_post(ctl + CW_BAR, MISC + 8);
    const int NGW = G * 8;
    float* mod = (float*)(AWS() + WS_MOD);
    bf16_t* XN = (bf16_t*)(AWS() + WS_XN); bf16_t* FM = (bf16_t*)(AWS() + WS_FM); bf16_t* HB = (bf16_t*)(AWS() + WS_H);
    bf16_t* PROJ = (bf16_t*)(AWS() + WS_PROJ); bf16_t* HEADS = (bf16_t*)(AWS() + WS_HEADS); bf16_t* ZB = (bf16_t*)(AWS() + WS_Z);

    for (int ph = ph_lo; ph < ph_hi; ++ph) {
        int tid = threadIdx.x; asm volatile("" : "+v"(tid));
        const int lane = tid & 63, wave = __builtin_amdgcn_readfirstlane(tid >> 6);
        const int gw = blockIdx.x * 8 + wave;
        if (ph == 0) {
#if !defined(NO_P0)
            phase_p0(lds, tid, lane, wave, G);
#endif
        } else if (ph == 1) {
            thin_resid(nullptr, AIN(I_X), nullptr, nullptr, nullptr, AIN(I_PREMIXG), mod + 1 * D, mod + 0 * D, XN, gw, NGW, lane);
        } else {
            const int l = (ph - 2) / 9, sp = (ph - 2) % 9;
            const float* modl = mod + (size_t)l * NB * NMODC;
            if (sp == 0 || sp == 2 || sp == 4 || sp == 6 || sp == 7) {
                unsigned char* ws = AWS();
                const bf16_t* A; const bf16_t* Bt; int N, K; pg8::EpiGen E; E.Z = nullptr; E.bias = nullptr;
                if (sp == 0)      { A = XN; Bt = (const bf16_t*)(ws + WS_WIN) + (size_t)l * INW * D; N = INW; K = D; E.O = PROJ; E.ldc = INW; E.mode = 0; }
                else if (sp == 2) { A = ZB; Bt = (const bf16_t*)(ws + WS_WGLU) + (size_t)l * SW * SW; N = SW; K = SW; E.O = HEADS + AW; E.ldc = D; E.mode = 2; E.Z = ZB; E.bias = AIN(I_BGLU) + (size_t)l * SW; }
                else if (sp == 4) { A = HEADS; Bt = (const bf16_t*)(ws + WS_WOUT) + (size_t)l * D * D; N = D; K = D; E.O = FM; E.ldc = D; E.mode = 0; }
                else if (sp == 6) { A = XN; Bt = (const bf16_t*)(ws + WS_WMI) + (size_t)l * FF * D; N = FF; K = D; E.O = HB; E.ldc = FF; E.mode = 1; }
                else              { A = HB; Bt = (const bf16_t*)(ws + WS_WMO) + (size_t)l * D * FF; N = D; K = FF; E.O = FM; E.ldc = D; E.mode = 0; }
                gemm_call(lds, A, Bt, N, K, E, tid);
            } else if (sp == 1) {
                for (int u = blockIdx.x; u < NB * (SEQ / 128); u += G) {
#if !defined(NO_ATTN)
                    attn_unit(lds, PROJ, HEADS, AIN(I_SINKS) + l * NQH, u / (SEQ / 128), u % (SEQ / 128), tid);
#endif
                }
                SsmParams spp;
                spp.lam_re = AIN(I_LAMRE) + (size_t)l * NGRP * NST; spp.lam_im = AIN(I_LAMIM) + (size_t)l * NGRP * NST; spp.log_dt = AIN(I_LOGDT) + (size_t)l * NGRP;
                spp.b_re = AIN(I_BRE) + (size_t)l * NGRP * NST * NCH; spp.b_im = AIN(I_BIM) + (size_t)l * NGRP * NST * NCH;
                spp.c_re = AIN(I_CRE) + (size_t)l * NGRP * NCH * NST; spp.c_im = AIN(I_CIM) + (size_t)l * NGRP * NCH * NST; spp.d_skip = AIN(I_DSKIP) + (size_t)l * SW;
                for (int u = blockIdx.x; u < NB * NGRP; u += G) {
#if !defined(NO_SSM)
                    ssm_unit(lds, PROJ, ZB, spp, u / NGRP, u % NGRP, tid);
#endif
                }
            } else if (sp == 3) {
                thin_ssm_norm(HEADS, gw, NGW, lane);
            } else if (sp == 5) {
                thin_resid(FM, l == 0 ? AIN(I_X) : AOUT(), AOUT(), modl + 2 * D, AIN(I_POSTMIXG) + (size_t)l * D,
                           AIN(I_PREMLPG) + (size_t)l * D, modl + 4 * D, modl + 3 * D, XN, gw, NGW, lane);
            } else {
                const bool lastl = (l == DEPTH - 1);
                thin_resid(FM, AOUT(), AOUT(), modl + 5 * D, AIN(I_POSTMLPG) + (size_t)l * D,
                           AIN(I_PREMIXG) + (size_t)(lastl ? l : l + 1) * D, modl + (lastl ? 0 : NB * NMODC) + 1 * D, modl + (lastl ? 0 : NB * NMODC) + 0 * D,
                           lastl ? nullptr : XN, gw, NGW, lane);
            }
        }
        if (ph + 1 < ph_hi) {
            if (ph == ph_lo) { asm volatile("s_waitcnt vmcnt(0)" ::: "memory"); __threadfence(); cg::this_grid().sync(); }
            else xcd_barrier(bar);
        }
    }
}

extern "C" void kernel_launch(void* const* d_in, const int* in_sizes, int n_in, void* d_out, int out_size, void* d_ws, size_t ws_size, hipStream_t stream) {
    static int grid = 0;
    if (grid == 0) {
        if (n_in != 25 || out_size != M * D || ws_size < WS_END) { fprintf(stderr, "kernel_launch: unexpected shapes (n_in %d out %d ws %zu)\n", n_in, out_size, ws_size); grid = -1; return; }
        int dev = 0, cus = 0, per_cu = 0;
        hipGetDevice(&dev); hipDeviceGetAttribute(&cus, hipDeviceAttributeMultiprocessorCount, dev);
        if (hipFuncSetAttribute((const void*)fwd_kernel, hipFuncAttributeMaxDynamicSharedMemorySize, LDS_BYTES) != hipSuccess) { fprintf(stderr, "kernel_launch: hipFuncSetAttribute failed\n"); grid = -1; return; }
        hipOccupancyMaxActiveBlocksPerMultiprocessor(&per_cu, (const void*)fwd_kernel, 512, LDS_BYTES);
        (void)hipGetLastError();
        if (per_cu < 1) per_cu = 1;
        grid = cus;
    }
    if (grid < 0) return;
    hipMemsetAsync((char*)d_ws + WS_CTL, 0, CTL_ZERO_BYTES, stream);
    Args a{};
    for (int i = 0; i < 25; ++i) a.in[i] = (const float*)d_in[i];
    a.out = (float*)d_out; a.ws = (unsigned char*)d_ws;
#if MK_MULTI
    for (int ph = 0; ph < N_PHASES; ++ph) {
        a.ph_lo = ph; a.ph_hi = ph + 1;
        hipLaunchKernelGGL(fwd_kernel, dim3(grid), dim3(512), LDS_BYTES, stream, a);
    }
#else
    a.ph_lo = 0; a.ph_hi = N_PHASES;
    void* args[] = {&a};
    hipError_t e = hipLaunchCooperativeKernel((const void*)fwd_kernel, dim3(grid), dim3(512), args, LDS_BYTES, stream);
    if (e != hipSuccess) fprintf(stderr, "cooperative launch failed: %s (grid %d)\n", hipGetErrorString(e), grid);
#endif
}
```

```cpp
#include <hip/hip_runtime.h>
#include <hip/hip_cooperative_groups.h>
#include <cstdio>
#include <cstdint>
namespace cg = cooperative_groups;

#ifndef MK_MULTI
#define MK_MULTI 0
#endif

#define GAS __attribute__((address_space(1)))
#define LAS __attribute__((address_space(3)))
typedef unsigned short bf16_t;
typedef short bf16x8 __attribute__((ext_vector_type(8)));
typedef short s16x4 __attribute__((ext_vector_type(4)));
typedef float f32x4 __attribute__((ext_vector_type(4)));
typedef float f32x2 __attribute__((ext_vector_type(2)));
typedef float f32x16 __attribute__((ext_vector_type(16)));
typedef unsigned u32x4 __attribute__((ext_vector_type(4)));
typedef unsigned u32x2 __attribute__((ext_vector_type(2)));

constexpr int D = 1024, NB = 8, SEQ = 4096, DEPTH = 4, M = NB * SEQ;
constexpr int AW = 512, SW = 512, NQH = 8, FF = 4096, INW = 1280, NMODC = 6 * D;
constexpr int NGRP = 32, NST = 64, NCH = 16;
constexpr float EPS = 1e-6f;
constexpr float LOG2E = 1.4426950408889634f;

constexpr size_t MiB = 1u << 20;
constexpr size_t WS_CTL = 0, CTL_ZERO_BYTES = 64 * 1024;
constexpr size_t WS_MOD = 1 * MiB;
constexpr size_t WS_WIN = 2 * MiB;
constexpr size_t WS_WOUT = 12 * MiB;
constexpr size_t WS_WGLU = 20 * MiB;
constexpr size_t WS_WMI = 22 * MiB;
constexpr size_t WS_WMO = 54 * MiB;
constexpr size_t WS_XN = 88 * MiB;
constexpr size_t WS_FM = 152 * MiB;
constexpr size_t WS_H = 216 * MiB;
constexpr size_t WS_PROJ = 216 * MiB;
constexpr size_t WS_HEADS = 296 * MiB;
constexpr size_t WS_Z = 360 * MiB;
constexpr size_t WS_END = 472 * MiB;
constexpr int CW_BAR = 1024;

constexpr int LDS_BYTES = 153600;
constexpr int MISC_OFF = LDS_BYTES - 256;

__device__ __forceinline__ unsigned cvt_pk_bf16(float lo, float hi) { unsigned r; asm volatile("v_cvt_pk_bf16_f32 %0, %1, %2" : "=v"(r) : "v"(lo), "v"(hi)); return r; }
__device__ __forceinline__ float bf_lo(unsigned w) { return __uint_as_float(w << 16); }
__device__ __forceinline__ float bf_hi(unsigned w) { return __uint_as_float(w & 0xffff0000u); }
__device__ __forceinline__ float bf2f(bf16_t v) { return __uint_as_float(((unsigned)v) << 16); }
__device__ __forceinline__ float wave_sum(float v) {
#pragma unroll
    for (int o = 1; o < 64; o <<= 1) v += __shfl_xor(v, o);
    return v;
}
__device__ __forceinline__ float fast_exp2(float x) { return __builtin_amdgcn_exp2f(x); }
__device__ __forceinline__ float sigmoidf_(float v) { return __builtin_amdgcn_rcpf(1.0f + fast_exp2(-LOG2E * v)); }
#define LDS_WAIT() asm volatile("s_waitcnt lgkmcnt(0)" ::: "memory")

namespace pg8 {
constexpr int BM = 256, BK = 64, HALF = 128, HTB = HALF * BK * 2, STAGE_BYTES = 8 * HTB, NXCD = 8, WGM = 8;
__host__ __device__ __forceinline__ int lds_byte(int r, int c) { const int st = (r >> 4) * 2 + (c >> 5), rr = r & 15, cc = c & 31, ob = rr * 64 + cc * 2; return st * 1024 + (ob ^ (((ob >> 9) & 1) << 5)); }
__host__ __device__ __forceinline__ void stage_rc(int b, int& R, int& C) { const int st = b / 1024, sb = b % 1024, swz = sb ^ (((sb >> 9) & 1) << 5); R = (st >> 1) * 16 + swz / 64; C = (st & 1) * 32 + (swz % 64) / 2; }
__host__ __device__ __forceinline__ int perm32(int rho) { const int n = rho >> 4, i = rho & 15; return 8 * (i >> 2) + 4 * n + (i & 3); }

struct Unit { int pm, pn; };
struct Gemm { const bf16_t* A; const bf16_t* Bt; int M, N, K; };

struct StaticOrder {
    int nM, nN, nwg, G, c;
    __host__ __device__ void init(int M_, int N_, int G_, int c_) { nM = M_ / BM; nN = N_ / BM; nwg = nM * nN; G = G_; c = c_; }
    __host__ __device__ bool next(int i, Unit& u) const {
        const long L = (long)i * G + c; if (L >= nwg) return false;
        int wgid = (int)L; { const int q = nwg / NXCD, r = nwg % NXCD, xcd = wgid % NXCD, off = wgid / NXCD; wgid = (xcd < r ? xcd * (q + 1) : r * (q + 1) + (xcd - r) * q) + off; }
        const int nig = WGM * nN, gid = wgid / nig, fm = gid * WGM, gsz = (nM - fm) < WGM ? (nM - fm) : WGM;
        u.pm = fm + ((wgid % nig) % gsz); u.pn = (wgid % nig) / gsz; return true;
    }
    __device__ __forceinline__ void a_ready(const Unit&) const {}
    __device__ __forceinline__ void done(const Unit&) const {}
};

struct EpiGen {
    static constexpr bool PERM = true, AFTER_DRAIN = false;
    bf16_t* O; int ldc; int mode; const bf16_t* Z; const float* bias;
    __device__ __forceinline__ void operator()(const f32x4 (&acc)[2][2][4][2], const Unit& u, int wr, int wc, int fr, int fq) const {
        const int row0 = u.pm * BM + wr * 64 + fr; const int col0 = u.pn * BM + wc * 32 + 8 * fq;
#pragma unroll
        for (int ai = 0; ai < 2; ++ai)
#pragma unroll
            for (int m = 0; m < 4; ++m) {
                const size_t row = (size_t)(row0 + ai * HALF + m * 16);
#pragma unroll
                for (int bj = 0; bj < 2; ++bj) {
                    const int col = col0 + bj * HALF;
                    f32x4 v0 = acc[ai][bj][m][0], v1 = acc[ai][bj][m][1];
                    if (mode == 1) {
#pragma unroll
                        for (int j = 0; j < 4; ++j) { const float a = fmaxf(v0[j], 0.f), b = fmaxf(v1[j], 0.f); v0[j] = a * a; v1[j] = b * b; }
                    } else if (mode == 2) {
                        const u32x4 zz = *(const u32x4*)(Z + row * 512 + col);
                        const f32x4 b0 = *(const f32x4*)(bias + col), b1 = *(const f32x4*)(bias + col + 4);
                        v0[0] = bf_lo(zz.x) * sigmoidf_(v0[0] + b0[0]); v0[1] = bf_hi(zz.x) * sigmoidf_(v0[1] + b0[1]);
                        v0[2] = bf_lo(zz.y) * sigmoidf_(v0[2] + b0[2]); v0[3] = bf_hi(zz.y) * sigmoidf_(v0[3] + b0[3]);
                        v1[0] = bf_lo(zz.z) * sigmoidf_(v1[0] + b1[0]); v1[1] = bf_hi(zz.z) * sigmoidf_(v1[1] + b1[1]);
                        v1[2] = bf_lo(zz.w) * sigmoidf_(v1[2] + b1[2]); v1[3] = bf_hi(zz.w) * sigmoidf_(v1[3] + b1[3]);
                    }
                    u32x4 w; w.x = cvt_pk_bf16(v0[0], v0[1]); w.y = cvt_pk_bf16(v0[2], v0[3]); w.z = cvt_pk_bf16(v1[0], v1[1]); w.w = cvt_pk_bf16(v1[2], v1[3]);
                    *(u32x4*)(O + row * ldc + col) = w;
                }
            }
    }
};

template <class Epi, class Sched, bool ALIGN_EPI = false, bool SP2 = false>
__device__ __forceinline__ void gemm_phase(LAS unsigned char* lds, const Gemm g, const Sched& S, const Epi& E, const int tid) {
    const int wid = __builtin_amdgcn_readfirstlane(tid >> 6), lane = tid & 63, wr = wid >> 2, wc = wid & 3, fr = lane & 15, fq = lane >> 4;
    const int K = g.K, nt = K / BK;
    unsigned voffA[2], voffB[2];
#pragma unroll
    for (int i = 0; i < 2; ++i) { int R, C; stage_rc(tid * 16 + i * 8192, R, C); const int Rb = Epi::PERM ? ((R & ~31) + perm32(R & 31)) : R;
        voffA[i] = (unsigned)(R * K + C) * 2u; voffB[i] = (unsigned)(Rb * K + C) * 2u; }
    const size_t kstep = (size_t)(BK * 2);
    const size_t hstep = (size_t)HALF * K * 2;
    const size_t tstep = 2 * hstep;
    const unsigned ldsw = (unsigned)wid * 1024u;
    const int aoff = lds_byte(wr * 64 + fr, fq * 8), boff = lds_byte(wc * 32 + fr, fq * 8);
#define PG8_SA(b, h) (((b) * 2 + (h)) * HTB)
#define PG8_SB(b, h) ((4 + (b) * 2 + (h)) * HTB)
#define PG8_STAGE(bufoff, gbase, voff) do { _Pragma("unroll") for (int _i = 0; _i < 2; ++_i) \
        __builtin_amdgcn_global_load_lds((const unsigned*)((const char*)(gbase) + (voff)[_i]), (LAS unsigned*)(lds + (bufoff) + ldsw + _i * 8192), 16, 0, 0); } while (0)
#define PG8_LDA(dst, b, h) do { _Pragma("unroll") for (int m = 0; m < 4; ++m) _Pragma("unroll") for (int k = 0; k < 2; ++k) dst[m][k] = *(const LAS bf16x8*)(lds + PG8_SA(b, h) + aoff + m * 2048 + k * 1024); } while (0)
#define PG8_LDB(dst, b, h) do { _Pragma("unroll") for (int n = 0; n < 2; ++n) _Pragma("unroll") for (int k = 0; k < 2; ++k) dst[n][k] = *(const LAS bf16x8*)(lds + PG8_SB(b, h) + boff + n * 2048 + k * 1024); } while (0)
#define PG8_MMA(ai, bj, At, Bt) do { __builtin_amdgcn_s_setprio(1); _Pragma("unroll") for (int m = 0; m < 4; ++m) _Pragma("unroll") for (int n = 0; n < 2; ++n) _Pragma("unroll") for (int k = 0; k < 2; ++k) \
        acc[ai][bj][m][n] = __builtin_amdgcn_mfma_f32_16x16x32_bf16(Bt[n][k], At[m][k], acc[ai][bj][m][n], 0, 0, 0); __builtin_amdgcn_s_setprio(0); } while (0)
#define PG8_WAIT_V(n) asm volatile("s_waitcnt vmcnt(" #n ")" ::: "memory")
#define PG8_WAIT_L(n) asm volatile("s_waitcnt lgkmcnt(" #n ")" ::: "memory")
#define PG8_BAR __builtin_amdgcn_s_barrier()
#define PG8_SCHED __builtin_amdgcn_sched_barrier(0)
    Unit cur, nxt; int ui = 0;
    if (!S.next(0, cur)) return;
    f32x4 acc[2][2][4][2];
#pragma unroll
    for (int a = 0; a < 2; ++a)
#pragma unroll
        for (int b = 0; b < 2; ++b)
#pragma unroll
            for (int m = 0; m < 4; ++m)
#pragma unroll
                for (int n = 0; n < 2; ++n) acc[a][b][m][n] = (f32x4){0.f, 0.f, 0.f, 0.f};
    bf16x8 At[4][2], B0[2][2], B1[2][2];
    const char* cA = (const char*)g.A + (size_t)cur.pm * tstep; const char* cB = (const char*)g.Bt + (size_t)cur.pn * tstep;
    S.a_ready(cur);
    if constexpr (SP2) {
        PG8_STAGE(PG8_SB(0, 0), cB, voffB); PG8_STAGE(PG8_SB(0, 1), cB + hstep, voffB); PG8_STAGE(PG8_SA(0, 0), cA, voffA); PG8_STAGE(PG8_SA(0, 1), cA + hstep, voffA);
        if (wr == 1) PG8_BAR;
        PG8_WAIT_V(2); PG8_BAR;
        PG8_STAGE(PG8_SB(1, 0), cB + kstep, voffB); PG8_STAGE(PG8_SA(1, 0), cA + kstep, voffA); PG8_STAGE(PG8_SB(1, 1), cB + hstep + kstep, voffB);
        PG8_WAIT_V(6); PG8_BAR;
    } else {
        PG8_STAGE(PG8_SB(0, 0), cB, voffB); PG8_STAGE(PG8_SA(0, 0), cA, voffA); PG8_STAGE(PG8_SB(0, 1), cB + hstep, voffB); PG8_STAGE(PG8_SA(0, 1), cA + hstep, voffA);
        if (wr == 1) PG8_BAR;
        PG8_WAIT_V(4); PG8_BAR;
        PG8_STAGE(PG8_SB(1, 0), cB + kstep, voffB); PG8_STAGE(PG8_SA(1, 0), cA + kstep, voffA); PG8_STAGE(PG8_SB(1, 1), cB + hstep + kstep, voffB);
        PG8_WAIT_V(6); PG8_BAR;
    }
    for (;;) {
        const bool has_next = S.next(ui + 1, nxt);
        const char* nA = has_next ? (const char*)g.A + (size_t)nxt.pm * tstep : cA; const char* nB = has_next ? (const char*)g.Bt + (size_t)nxt.pn * tstep : cB;
        for (int t = 0; t < nt; t += 2) {
            const bool last = (t == nt - 2);
            const char* a1 = cA + (size_t)(t + 1) * kstep;
            const char* a2 = last ? nA : cA + (size_t)(t + 2) * kstep; const char* b2 = last ? nB : cB + (size_t)(t + 2) * kstep;
            const char* a3 = a2 + kstep; const char* b3 = b2 + kstep;
            if (last && has_next) S.a_ready(nxt);
            if constexpr (SP2) {
            PG8_LDB(B0, 0, 0); PG8_LDB(B1, 0, 1); PG8_SCHED; PG8_LDA(At, 0, 0); PG8_STAGE(PG8_SA(1, 1), a1 + hstep, voffA);
            PG8_WAIT_V(8); PG8_WAIT_L(0); PG8_BAR; PG8_MMA(0, 0, At, B0); PG8_MMA(0, 1, At, B1); PG8_BAR; PG8_SCHED;
            PG8_LDA(At, 0, 1); PG8_STAGE(PG8_SB(0, 0), b2, voffB); PG8_STAGE(PG8_SB(0, 1), b2 + hstep, voffB); PG8_STAGE(PG8_SA(0, 0), a2, voffA);
            PG8_WAIT_V(8); PG8_WAIT_L(0); PG8_BAR; PG8_MMA(1, 0, At, B0); PG8_MMA(1, 1, At, B1); PG8_BAR; PG8_SCHED;
            PG8_LDB(B0, 1, 0); PG8_LDB(B1, 1, 1); PG8_SCHED; PG8_LDA(At, 1, 0); PG8_STAGE(PG8_SA(0, 1), a2 + hstep, voffA);
            PG8_WAIT_V(8); PG8_WAIT_L(0); PG8_BAR; PG8_MMA(0, 0, At, B0); PG8_MMA(0, 1, At, B1); PG8_BAR; PG8_SCHED;
            PG8_LDA(At, 1, 1); PG8_STAGE(PG8_SB(1, 0), b3, voffB); PG8_STAGE(PG8_SB(1, 1), b3 + hstep, voffB); PG8_STAGE(PG8_SA(1, 0), a3, voffA);
            PG8_WAIT_V(8); PG8_WAIT_L(0); PG8_BAR; PG8_MMA(1, 0, At, B0); PG8_MMA(1, 1, At, B1); PG8_BAR; PG8_SCHED;
            } else {
            PG8_LDB(B0, 0, 0); PG8_SCHED; PG8_LDA(At, 0, 0); PG8_STAGE(PG8_SA(1, 1), a1 + hstep, voffA);
            PG8_WAIT_L(8); PG8_BAR; PG8_WAIT_L(0); PG8_MMA(0, 0, At, B0); PG8_BAR; PG8_SCHED;
            PG8_LDB(B1, 0, 1); PG8_STAGE(PG8_SB(0, 0), b2, voffB);
            PG8_BAR; PG8_WAIT_L(0); PG8_MMA(0, 1, At, B1); PG8_BAR;
            PG8_LDA(At, 0, 1); PG8_STAGE(PG8_SA(0, 0), a2, voffA);
            PG8_BAR; PG8_WAIT_L(0); PG8_MMA(1, 0, At, B0); PG8_BAR; PG8_SCHED;
            PG8_STAGE(PG8_SB(0, 1), b2 + hstep, voffB);
            PG8_WAIT_V(6); PG8_BAR; PG8_MMA(1, 1, At, B1); PG8_BAR;
            PG8_LDB(B0, 1, 0); PG8_SCHED; PG8_LDA(At, 1, 0); PG8_STAGE(PG8_SA(0, 1), a2 + hstep, voffA);
            PG8_WAIT_L(8); PG8_BAR; PG8_WAIT_L(0); PG8_MMA(0, 0, At, B0); PG8_BAR; PG8_SCHED;
            PG8_LDB(B1, 1, 1); PG8_STAGE(PG8_SB(1, 0), b3, voffB);
            PG8_BAR; PG8_WAIT_L(0); PG8_MMA(0, 1, At, B1); PG8_BAR;
            PG8_LDA(At, 1, 1); PG8_STAGE(PG8_SA(1, 0), a3, voffA);
            PG8_BAR; PG8_WAIT_L(0); PG8_MMA(1, 0, At, B0); PG8_BAR; PG8_SCHED;
            PG8_STAGE(PG8_SB(1, 1), b3 + hstep, voffB);
            PG8_WAIT_V(6); PG8_BAR; PG8_MMA(1, 1, At, B1); PG8_BAR;
            }
        }
        if constexpr (ALIGN_EPI) { if (wr == 0) PG8_BAR; }
        if constexpr (!Epi::AFTER_DRAIN) { E(acc, cur, wr, wc, fr, fq); S.done(cur); }
        if (!has_next) break;
#pragma unroll
        for (int a = 0; a < 2; ++a)
#pragma unroll
            for (int b = 0; b < 2; ++b)
#pragma unroll
                for (int m = 0; m < 4; ++m)
#pragma unroll
                    for (int n = 0; n < 2; ++n) acc[a][b][m][n] = (f32x4){0.f, 0.f, 0.f, 0.f};
        cur = nxt; cA = nA; cB = nB; ++ui;
        if constexpr (ALIGN_EPI) { if (wr == 1) PG8_BAR; }
    }
    PG8_WAIT_V(0);
    if constexpr (!ALIGN_EPI) { if (wr == 0) PG8_BAR; }
    PG8_BAR;
#undef PG8_SA
#undef PG8_SB
#undef PG8_STAGE
#undef PG8_LDA
#undef PG8_LDB
#undef PG8_MMA
#undef PG8_WAIT_V
#undef PG8_WAIT_L
#undef PG8_BAR
#undef PG8_SCHED
}
}

__device__ __forceinline__ void gemm_call(LAS unsigned char* lds, const bf16_t* A, const bf16_t* Bt, int N, int K, const pg8::EpiGen& E, int tid) {
#if !defined(NO_GEMM)
    pg8::Gemm g{A, Bt, M, N, K};
    pg8::StaticOrder S; S.init(M, N, (int)gridDim.x, (int)blockIdx.x);
    pg8::gemm_phase<pg8::EpiGen, pg8::StaticOrder, true, true>(lds, g, S, E, tid);
#endif
}

#define XB_TMO      128
#define XB_XCNT(j)  (256  + 64 * (j))
#define XB_XSUB(j)  (1280 + 64 * (j))
#define XB_XGEN(j)  (2304 + 64 * (j))
#define XB_TOP      3328
#define XB_TOPGEN   3392
#define XCD_BAR_WORDS 3456
#define XB_SPIN_CAP (1u << 20)
__device__ __forceinline__ unsigned xb_ld(unsigned* p)              { return __hip_atomic_load(p, __ATOMIC_RELAXED, __HIP_MEMORY_SCOPE_AGENT); }
__device__ __forceinline__ unsigned xb_add(unsigned* p, unsigned v) { return __hip_atomic_fetch_add(p, v, __ATOMIC_RELAXED, __HIP_MEMORY_SCOPE_AGENT); }
__device__ __forceinline__ unsigned xb_xcc_id() { return (unsigned)__builtin_amdgcn_s_getreg((3 << 11) | 20) & 0xFu; }
#define XB_SPIN(cond, bar) do { unsigned _sp = 0; while (cond) { __builtin_amdgcn_s_sleep(1); \
    if ((++_sp & 255u) == 0u) { if (xb_ld(&(bar)[XB_TMO])) break; if (_sp > XB_SPIN_CAP) { atomicAdd(&(bar)[XB_TMO], 1u); break; } } } } while (0)
struct XcdBarrier { unsigned* bar; unsigned x; volatile LAS unsigned* st; };
__device__ __forceinline__ XcdBarrier xcd_barrier_post(unsigned* bar, volatile LAS unsigned* st) {
    XcdBarrier b; b.bar = bar; b.x = xb_xcc_id(); b.st = st;
    if (threadIdx.x == 0) (void)xb_add(&bar[XB_XCNT(b.x)], 1u);
    return b;
}
__device__ __forceinline__ void xcd_barrier_complete(unsigned* bar, unsigned x, unsigned& nloc, unsigned& nx) {
    const unsigned G = gridDim.x * gridDim.y * gridDim.z;
    unsigned sum, cnt, mine, sp = 0u;
    for (;;) {
        sum = 0u; cnt = 0u; mine = 0u;
#pragma unroll
        for (unsigned j = 0; j < 16; ++j) { const unsigned c = xb_ld(&bar[XB_XCNT(j)]); sum += c; cnt += (c > 0u) ? 1u : 0u; mine = (j == x) ? c : mine; }
        if (sum == G) break;
        __builtin_amdgcn_s_sleep(1);
        if ((++sp & 255u) == 0u) { if (xb_ld(&bar[XB_TMO])) break; if (sp > XB_SPIN_CAP) { atomicAdd(&bar[XB_TMO], 1u); break; } }
    }
    nloc = mine > 0u ? mine : 1u; nx = cnt > 0u ? cnt : 1u;
}
__device__ __forceinline__ void xcd_barrier(const XcdBarrier& b) {
    asm volatile("s_waitcnt vmcnt(0)" ::: "memory");
    __syncthreads();
    if (threadIdx.x == 0) {
        unsigned* bar = b.bar;
        __builtin_amdgcn_s_waitcnt(0);
        unsigned nloc = b.st[0], nx = b.st[1];
        if (nloc == 0u) { xcd_barrier_complete(bar, b.x, nloc, nx); b.st[0] = nloc; b.st[1] = nx; }
        const unsigned old = xb_add(&bar[XB_XSUB(b.x)], 1u);
        const unsigned gen = old / nloc;
        if (old + 1u == (gen + 1u) * nloc) {
            __builtin_amdgcn_fence(__ATOMIC_RELEASE, "agent");
            asm volatile("s_waitcnt vmcnt(0)" ::: "memory");
            const unsigned og = xb_add(&bar[XB_TOP], 1u);
            const unsigned tg = og / nx;
            if (og + 1u == (tg + 1u) * nx) xb_add(&bar[XB_TOPGEN], 1u);
            else XB_SPIN(xb_ld(&bar[XB_TOPGEN]) == tg, bar);
            __builtin_amdgcn_fence(__ATOMIC_ACQUIRE, "agent");
            xb_add(&bar[XB_XGEN(b.x)], 1u);
            asm volatile("s_waitcnt vmcnt(0)" ::: "memory");
        } else {
            XB_SPIN(xb_ld(&bar[XB_XGEN(b.x)]) == gen, bar);
            __builtin_amdgcn_fence(__ATOMIC_ACQUIRE, "agent");
            asm volatile("s_waitcnt vmcnt(0)" ::: "memory");
        }
    }
    __syncthreads();
}

struct Args {
    const float* in[25];
    float* out; unsigned char* ws;
    int ph_lo, ph_hi;
};
enum { I_X = 0, I_C, I_WADA, I_BADA, I_PREMIXG, I_WIN, I_SINKS, I_LAMRE, I_LAMIM, I_LOGDT, I_BRE, I_BIM, I_CRE, I_CIM, I_DSKIP, I_WGLU, I_BGLU,
       I_ATTNG, I_SSMG, I_WOUT, I_POSTMIXG, I_PREMLPG, I_WMI, I_WMO, I_POSTMLPG };

typedef const unsigned char __attribute__((address_space(4)))* kargp_t;
__device__ __forceinline__ const float* karg_in(int i) {
    kargp_t kp = (kargp_t)__builtin_amdgcn_kernarg_segment_ptr();
    asm volatile("" : "+s"(kp));
    return *(const float* const __attribute__((address_space(4)))*)(kp + 8 * i);
}
__device__ __forceinline__ float* karg_out() { kargp_t kp = (kargp_t)__builtin_amdgcn_kernarg_segment_ptr(); asm volatile("" : "+s"(kp)); return *(float* const __attribute__((address_space(4)))*)(kp + 8 * 25); }
__device__ __forceinline__ unsigned char* karg_ws() { kargp_t kp = (kargp_t)__builtin_amdgcn_kernarg_segment_ptr(); asm volatile("" : "+s"(kp)); return *(unsigned char* const __attribute__((address_space(4)))*)(kp + 8 * 26); }
__device__ __forceinline__ int karg_i(int i) { kargp_t kp = (kargp_t)__builtin_amdgcn_kernarg_segment_ptr(); asm volatile("" : "+s"(kp)); return *(const int __attribute__((address_space(4)))*)(kp + 8 * 27 + 4 * i); }
#define AIN(i) karg_in(i)
#define AWS() karg_ws()
#define AOUT() karg_out()

__device__ __forceinline__ void p0_transpose_item(const float* W, int K, int N, bf16_t* WT, const float* kscale, LAS float* scr, int item, int lane) {
    const int nblk = N / 32, kb = item / nblk, nb = item % nblk, k0 = 64 * kb, n0 = 32 * nb;
#pragma unroll 8
    for (int i = 0; i < 32; ++i) { const int kk = 2 * i + (lane >> 5); float v = W[(size_t)(k0 + kk) * N + n0 + (lane & 31)]; if (kscale) v *= kscale[k0 + kk]; scr[kk * 33 + (lane & 31)] = v; }
    LDS_WAIT(); asm volatile("" ::: "memory");
    const int c = lane & 7;
#pragma unroll
    for (int j = 0; j < 4; ++j) { const int n = (lane >> 3) + 8 * j; const LAS float* s = scr + (8 * c) * 33 + n;
        u32x4 o; o.x = cvt_pk_bf16(s[0 * 33], s[1 * 33]); o.y = cvt_pk_bf16(s[2 * 33], s[3 * 33]); o.z = cvt_pk_bf16(s[4 * 33], s[5 * 33]); o.w = cvt_pk_bf16(s[6 * 33], s[7 * 33]);
        *(u32x4*)(WT + (size_t)(n0 + n) * K + k0 + 8 * c) = o; }
    LDS_WAIT(); asm volatile("" ::: "memory");
}

__device__ __forceinline__ void phase_p0(LAS unsigned char* lds, int tid, int lane, int wave, int G) {
    LAS float* cact = (LAS float*)(lds + 67584);
    LAS float* red = (LAS float*)(lds + 100352);
    float* mod = (float*)(AWS() + WS_MOD);
    {
        const float* c = AIN(I_C);
        for (int e = tid; e < NB * D; e += 512) { const float v = c[e]; cact[e] = v / (1.0f + __expf(-v)); }
        __syncthreads();
        for (int item = blockIdx.x; item < DEPTH * (NMODC / 64); item += G) {
            const int l = item / (NMODC / 64), cb = item % (NMODC / 64), col = cb * 64 + lane;
            const float* w = AIN(I_WADA) + (size_t)l * D * NMODC + col;
            float acc[8];
#pragma unroll
            for (int b = 0; b < 8; ++b) acc[b] = 0.f;
            const int k0 = wave * 128;
#pragma unroll 4
            for (int k = k0; k < k0 + 128; ++k) {
                const float wv = w[(size_t)k * NMODC];
#pragma unroll
                for (int b = 0; b < 8; ++b) acc[b] += wv * cact[b * D + k];
            }
#pragma unroll
            for (int b = 0; b < 8; ++b) red[(wave * 8 + b) * 64 + lane] = acc[b];
            __syncthreads();
            {
                const int b = wave; float s = 0.f;
#pragma unroll
                for (int w8 = 0; w8 < 8; ++w8) s += red[(w8 * 8 + b) * 64 + lane];
                mod[((size_t)l * NB + b) * NMODC + col] = s + AIN(I_BADA)[(size_t)l * NMODC + col];
            }
            __syncthreads();
        }
    }
    LAS float* scr = (LAS float*)(lds + wave * 8448);
    const int gw = blockIdx.x * 8 + wave, NGW = G * 8;
    constexpr int I_IN = (D / 64) * (INW / 32), I_OUT = (D / 64) * (D / 32), I_GLU = (SW / 64) * (SW / 32), I_MI = (D / 64) * (FF / 32), I_MO = (FF / 64) * (D / 32);
    constexpr int PER_L = I_IN + I_OUT + I_GLU + I_MI + I_MO;
    for (int it = gw; it < DEPTH * PER_L; it += NGW) {
        const int l = it / PER_L; int r = it % PER_L;
        if (r < I_IN) { p0_transpose_item(AIN(I_WIN) + (size_t)l * D * INW, D, INW, (bf16_t*)(AWS() + WS_WIN) + (size_t)l * INW * D, nullptr, scr, r, lane); continue; } r -= I_IN;
        if (r < I_OUT) {
            const int kb = r / (D / 32); const float* ks = (kb * 64 < AW) ? (AIN(I_ATTNG) + (size_t)l * AW) : (AIN(I_SSMG) + (size_t)l * SW - AW);
            p0_transpose_item(AIN(I_WOUT) + (size_t)l * D * D, D, D, (bf16_t*)(AWS() + WS_WOUT) + (size_t)l * D * D, ks, scr, r, lane); continue; } r -= I_OUT;
        if (r < I_GLU) { p0_transpose_item(AIN(I_WGLU) + (size_t)l * SW * SW, SW, SW, (bf16_t*)(AWS() + WS_WGLU) + (size_t)l * SW * SW, nullptr, scr, r, lane); continue; } r -= I_GLU;
        if (r < I_MI) { p0_transpose_item(AIN(I_WMI) + (size_t)l * D * FF, D, FF, (bf16_t*)(AWS() + WS_WMI) + (size_t)l * FF * D, nullptr, scr, r, lane); continue; } r -= I_MI;
        p0_transpose_item(AIN(I_WMO) + (size_t)l * FF * D, FF, D, (bf16_t*)(AWS() + WS_WMO) + (size_t)l * D * FF, nullptr, scr, r, lane);
    }
}

__device__ __forceinline__ void thin_resid(const bf16_t* src, const float* xs, float* xd, const float* gate, const float* pg,
                                           const float* ng, const float* nsc, const float* nsh, bf16_t* xn, int gw, int NGW, int lane) {
    for (int m = gw; m < M; m += NGW) {
        const int b = m >> 12;
        f32x4 xv[4];
#pragma unroll
        for (int j = 0; j < 4; ++j) xv[j] = ((const f32x4*)(xs + (size_t)m * D))[lane + 64 * j];
        if (src) {
            f32x4 f[4]; float ss = 0.f;
#pragma unroll
            for (int j = 0; j < 4; ++j) { const u32x2 w = ((const u32x2*)(src + (size_t)m * D))[lane + 64 * j];
                f[j] = (f32x4){bf_lo(w.x), bf_hi(w.x), bf_lo(w.y), bf_hi(w.y)}; ss += (f[j].x * f[j].x + f[j].y * f[j].y) + (f[j].z * f[j].z + f[j].w * f[j].w); }
            const float rstd = rsqrtf(wave_sum(ss) * (1.0f / D) + EPS);
#pragma unroll
            for (int j = 0; j < 4; ++j) { const int col = 4 * (lane + 64 * j);
                const f32x4 gt = *(const f32x4*)(gate + (size_t)b * NMODC + col), pgv = *(const f32x4*)(pg + col);
                xv[j] += gt * pgv * (f[j] * rstd);
                ((f32x4*)(xd + (size_t)m * D))[lane + 64 * j] = xv[j]; }
        }
        if (xn) {
            float ss = 0.f;
#pragma unroll
            for (int j = 0; j < 4; ++j) ss += (xv[j].x * xv[j].x + xv[j].y * xv[j].y) + (xv[j].z * xv[j].z + xv[j].w * xv[j].w);
            const float rstd = rsqrtf(wave_sum(ss) * (1.0f / D) + EPS);
#pragma unroll
            for (int j = 0; j < 4; ++j) { const int col = 4 * (lane + 64 * j);
                const f32x4 g = *(const f32x4*)(ng + col), sc = *(const f32x4*)(nsc + (size_t)b * NMODC + col), sh = *(const f32x4*)(nsh + (size_t)b * NMODC + col);
                const f32x4 h = xv[j] * rstd * g * (1.0f + sc) + sh;
                u32x2 w; w.x = cvt_pk_bf16(h.x, h.y); w.y = cvt_pk_bf16(h.z, h.w);
                ((u32x2*)(xn + (size_t)m * D))[lane + 64 * j] = w; }
        }
    }
}
__device__ __forceinline__ void thin_ssm_norm(bf16_t* heads, int gw, int NGW, int lane) {
    for (int m = gw; m < M; m += NGW) {
        u32x4* p = (u32x4*)(heads + (size_t)m * D + AW) + lane;
        const u32x4 w = *p;
        float v[8] = {bf_lo(w.x), bf_hi(w.x), bf_lo(w.y), bf_hi(w.y), bf_lo(w.z), bf_hi(w.z), bf_lo(w.w), bf_hi(w.w)};
        float ss = 0.f;
#pragma unroll
        for (int i = 0; i < 8; ++i) ss += v[i] * v[i];
        const float rstd = rsqrtf(wave_sum(ss) * (1.0f / SW) + EPS);
        u32x4 o; o.x = cvt_pk_bf16(v[0] * rstd, v[1] * rstd); o.y = cvt_pk_bf16(v[2] * rstd, v[3] * rstd); o.z = cvt_pk_bf16(v[4] * rstd, v[5] * rstd); o.w = cvt_pk_bf16(v[6] * rstd, v[7] * rstd);
        *p = o;
    }
}

__device__ __forceinline__ int crow(int r, int hi) { return (r & 3) + 8 * (r >> 2) + 4 * hi; }
constexpr int KS_PITCH = 72, VT_PITCH = 260;
constexpr int ATT_VT_OFF = 2 * 256 * KS_PITCH * 2;
constexpr int ATT_SSQ_OFF = ATT_VT_OFF + 2 * 64 * VT_PITCH * 2;
__device__ __forceinline__ void attn_unit(LAS unsigned char* lds, const bf16_t* PROJ, bf16_t* HEADS, const float* sinks, int b, int n, int tid) {
    const int lane = tid & 63, wave = __builtin_amdgcn_readfirstlane(tid >> 6), r32 = lane & 31, hi = lane >> 5;
    LAS bf16_t* Ks = (LAS bf16_t*)lds;
    LAS bf16_t* VT = (LAS bf16_t*)(lds + ATT_VT_OFF);
    LAS float* SSQ = (LAS float*)(lds + ATT_SSQ_OFF);
    const long rowq0 = (long)b * SEQ + n * 128;
    const long rowk0 = rowq0 - 128;
#pragma unroll
    for (int i = 0; i < 8; ++i) {
        const int id = i * 512 + tid, key = id >> 4, rem = id & 15, kvh = rem >> 3, pc = rem & 7;
        u32x4 v = (u32x4){0u, 0u, 0u, 0u};
        if (n > 0 || key >= 128) v = *(const u32x4*)(PROJ + (size_t)(rowk0 + key) * INW + 512 + kvh * 64 + pc * 8);
        *(LAS u32x4*)(Ks + (kvh * 256 + key) * KS_PITCH + pc * 8) = v;
    }
    {
        const int kp = lane & 15, q = lane >> 4, key0 = wave * 32 + 2 * kp;
#pragma unroll
        for (int kvh = 0; kvh < 2; ++kvh)
#pragma unroll
            for (int ph = 0; ph < 2; ++ph) {
                const int pc = q + 4 * ph;
                u32x4 va = (u32x4){0u, 0u, 0u, 0u}, vc = (u32x4){0u, 0u, 0u, 0u};
                if (n > 0 || key0 >= 128) {
                    va = *(const u32x4*)(PROJ + (size_t)(rowk0 + key0) * INW + 640 + kvh * 64 + pc * 8);
                    vc = *(const u32x4*)(PROJ + (size_t)(rowk0 + key0 + 1) * INW + 640 + kvh * 64 + pc * 8);
                }
                LAS bf16_t* dst = VT + (kvh * 64 + pc * 8) * VT_PITCH + key0;
#pragma unroll
                for (int t = 0; t < 4; ++t) {
                    const unsigned wa = va[t], wc = vc[t];
                    *(LAS unsigned*)(dst + (2 * t) * VT_PITCH) = (wa & 0xffffu) | (wc << 16);
                    *(LAS unsigned*)(dst + (2 * t + 1) * VT_PITCH) = (wa >> 16) | (wc & 0xffff0000u);
                }
            }
    }
    __syncthreads();
    const int h = wave, kvh = h >> 2;
    const float slope2 = exp2f(-(float)(h + 1)) * LOG2E;
    const float sink2 = sinks[h] * LOG2E;
    const float sc2 = 0.125f * LOG2E;
    for (int i = 0; i < 4; ++i) {
        bf16x8 qf[4];
#pragma unroll
        for (int dd = 0; dd < 4; ++dd) qf[dd] = *(const bf16x8*)(PROJ + (size_t)(rowq0 + 32 * i + r32) * INW + h * 64 + dd * 16 + hi * 8);
        f32x16 s[5];
#pragma unroll
        for (int kt = 0; kt < 5; ++kt) {
#pragma unroll
            for (int r = 0; r < 16; ++r) s[kt][r] = 0.f;
#pragma unroll
            for (int dd = 0; dd < 4; ++dd) {
                const bf16x8 kf = *(const LAS bf16x8*)(Ks + (kvh * 256 + 32 * (i + kt) + r32) * KS_PITCH + dd * 16 + hi * 8);
                s[kt] = __builtin_amdgcn_mfma_f32_32x32x16_bf16(kf, qf[dd], s[kt], 0, 0, 0);
            }
        }
        float mx = sink2;
        int r32v = r32; asm volatile("" : "+v"(r32v));
        const float fbase = (float)(128 + r32v - 4 * hi);
#pragma unroll
        for (int kt = 0; kt < 5; ++kt) {
            const bool tile_ok = (n > 0) || (i + kt >= 4);
#pragma unroll
            for (int r = 0; r < 16; ++r) {
                const int c0 = (r & 3) + 8 * (r >> 2);
                const float diff = fbase - (float)(32 * kt + c0);
                bool valid = tile_ok;
                if (kt == 0) valid = valid && (diff < 128.0f);
                if (kt == 4) valid = valid && (diff >= 0.0f);
                float v = s[kt][r] * sc2 - slope2 * diff;
                v = valid ? v : -1e30f;
                s[kt][r] = v; mx = fmaxf(mx, v);
            }
        }
        mx = fmaxf(mx, __shfl_xor(mx, 32));
        float lsum = 0.f;
#pragma unroll
        for (int kt = 0; kt < 5; ++kt)
#pragma unroll
            for (int r = 0; r < 16; ++r) { const float p = fast_exp2(s[kt][r] - mx); s[kt][r] = p; lsum += p; }
        lsum += __shfl_xor(lsum, 32);
        lsum += fast_exp2(sink2 - mx);
        const float linv = 1.0f / lsum;
        f32x16 o[2];
#pragma unroll
        for (int r = 0; r < 16; ++r) { o[0][r] = 0.f; o[1][r] = 0.f; }
#pragma unroll
        for (int kt = 0; kt < 5; ++kt)
#pragma unroll
            for (int kk = 0; kk < 2; ++kk) {
                u32x4 pw;
                pw.x = cvt_pk_bf16(s[kt][8 * kk + 0], s[kt][8 * kk + 1]); pw.y = cvt_pk_bf16(s[kt][8 * kk + 2], s[kt][8 * kk + 3]);
                pw.z = cvt_pk_bf16(s[kt][8 * kk + 4], s[kt][8 * kk + 5]); pw.w = cvt_pk_bf16(s[kt][8 * kk + 6], s[kt][8 * kk + 7]);
                const bf16x8 pa = __builtin_bit_cast(bf16x8, pw);
                const int kbase = 32 * (i + kt) + 16 * kk + 4 * hi;
#pragma unroll
                for (int dt = 0; dt < 2; ++dt) {
                    const LAS bf16_t* vp = VT + (kvh * 64 + 32 * dt + r32) * VT_PITCH + kbase;
                    const s16x4 lo = *(const LAS s16x4*)vp, hi4 = *(const LAS s16x4*)(vp + 8);
                    const bf16x8 vb = (bf16x8){lo[0], lo[1], lo[2], lo[3], hi4[0], hi4[1], hi4[2], hi4[3]};
                    o[dt] = __builtin_amdgcn_mfma_f32_32x32x16_bf16(pa, vb, o[dt], 0, 0, 0);
                }
            }
#pragma unroll
        for (int r = 0; r < 16; ++r) {
            const float li = __shfl(linv, crow(r, hi));
            o[0][r] *= li; o[1][r] *= li;
            float q = o[0][r] * o[0][r] + o[1][r] * o[1][r];
            q += __shfl_xor(q, 1); q += __shfl_xor(q, 2); q += __shfl_xor(q, 4); q += __shfl_xor(q, 8); q += __shfl_xor(q, 16);
            if (r32 == 0) SSQ[(32 * i + crow(r, hi)) * 8 + h] = q;
        }
        __syncthreads();
#pragma unroll
        for (int r = 0; r < 16; ++r) {
            const int qrow = 32 * i + crow(r, hi);
            const f32x4 a0 = *(const LAS f32x4*)(SSQ + qrow * 8), a1 = *(const LAS f32x4*)(SSQ + qrow * 8 + 4);
            const float tot = (a0.x + a0.y) + (a0.z + a0.w) + (a1.x + a1.y) + (a1.z + a1.w);
            const float rstd = rsqrtf(tot * (1.0f / AW) + EPS);
            bf16_t* op = HEADS + (size_t)(rowq0 + qrow) * D + h * 64 + r32;
            op[0] = (bf16_t)(cvt_pk_bf16(o[0][r] * rstd, 0.f) & 0xffffu);
            op[32] = (bf16_t)(cvt_pk_bf16(o[1][r] * rstd, 0.f) & 0xffffu);
        }
    }
    __syncthreads();
}

constexpr int SSM_WAVE_BYTES = 12800, BU_PITCH = 132, HS_PITCH = 136;
constexpr int SSM_BB_OFF = 8 * SSM_WAVE_BYTES, SSM_CM_OFF = SSM_BB_OFF + 4096, SSM_AB_OFF = SSM_CM_OFF + 16 * HS_PITCH * 2, SSM_SG_OFF = SSM_AB_OFF + 512;
struct SsmParams { const float *lam_re, *lam_im, *log_dt, *b_re, *b_im, *c_re, *c_im, *d_skip; };
__device__ __forceinline__ void ssm_unit(LAS unsigned char* lds, const bf16_t* PROJ, bf16_t* Z, const SsmParams& sp, int b, int g, int tid) {
    const int lane = tid & 63, wave = __builtin_amdgcn_readfirstlane(tid >> 6), fr = lane & 15, fq = lane >> 4;
    LAS float* BU = (LAS float*)(lds + wave * SSM_WAVE_BYTES);
    LAS bf16_t* HS = (LAS bf16_t*)(lds + wave * SSM_WAVE_BYTES + 8448);
    LAS bf16_t* BB = (LAS bf16_t*)(lds + SSM_BB_OFF);
    LAS bf16_t* CM = (LAS bf16_t*)(lds + SSM_CM_OFF);
    LAS float* AB = (LAS float*)(lds + SSM_AB_OFF);
    LAS float* SG = (LAS float*)(lds + SSM_SG_OFF);
    if (tid < 64) {
        const int p = tid;
        const float dt = expf(sp.log_dt[g]);
        const float lr = sp.lam_re[g * NST + p], li = sp.lam_im[g * NST + p];
        const float mag = expf(lr * dt), ang = li * dt;
        float sn, cs; sincosf(ang, &sn, &cs);
        const float abr = mag * cs, abi = mag * sn;
        const float nr = abr - 1.0f, ni = abi, den = lr * lr + li * li;
        const float f_r = (nr * lr + ni * li) / den, f_i = (ni * lr - nr * li) / den;
        AB[2 * p] = abr; AB[2 * p + 1] = abi;
        const float* br = sp.b_re + (size_t)(g * NST + p) * NCH; const float* bi = sp.b_im + (size_t)(g * NST + p) * NCH;
#pragma unroll
        for (int c = 0; c < NCH; c += 2) {
            const float r0 = f_r * br[c] - f_i * bi[c], i0 = f_r * bi[c] + f_i * br[c];
            const float r1 = f_r * br[c + 1] - f_i * bi[c + 1], i1 = f_r * bi[c + 1] + f_i * br[c + 1];
            *(LAS unsigned*)(BB + (2 * p) * NCH + c) = cvt_pk_bf16(r0, r1);
            *(LAS unsigned*)(BB + (2 * p + 1) * NCH + c) = cvt_pk_bf16(i0, i1);
        }
    }
    for (int e = tid; e < NCH * 128; e += 512) {
        const int c = e >> 7, k = e & 127, p = k >> 1;
        const float v = (k & 1) ? -sp.c_im[(size_t)(g * NCH + c) * NST + p] : sp.c_re[(size_t)(g * NCH + c) * NST + p];
        CM[c * HS_PITCH + k] = (bf16_t)(cvt_pk_bf16(v, 0.f) & 0xffffu);
    }
    __syncthreads();
    bf16x8 bbf[8], cmf[4];
#pragma unroll
    for (int t = 0; t < 8; ++t) { bbf[t] = (bf16x8){0, 0, 0, 0, 0, 0, 0, 0}; if (fq < 2) bbf[t] = *(const LAS bf16x8*)(BB + (16 * t + fr) * NCH + 8 * fq); }
#pragma unroll
    for (int s = 0; s < 4; ++s) cmf[s] = *(const LAS bf16x8*)(CM + fr * HS_PITCH + 32 * s + 8 * fq);
    const float dsk = sp.d_skip[g * NCH + fr];
    const float ar = AB[2 * lane], ai = AB[2 * lane + 1];
    const size_t row0 = (size_t)b * SEQ + wave * 512;
    const bf16_t* ubase = PROJ + row0 * INW + 768 + g * NCH;
    float hr = 0.f, hi_ = 0.f;
    for (int ch = 0; ch < 32; ++ch) {
        bf16x8 uf = (bf16x8){0, 0, 0, 0, 0, 0, 0, 0};
        if (fq < 2) uf = *(const bf16x8*)(ubase + (size_t)(ch * 16 + fr) * INW + 8 * fq);
#pragma unroll
        for (int t = 0; t < 8; ++t) {
            const f32x4 d = __builtin_amdgcn_mfma_f32_16x16x32_bf16(bbf[t], uf, (f32x4){0.f, 0.f, 0.f, 0.f}, 0, 0, 0);
            *(LAS f32x4*)(BU + fr * BU_PITCH + 16 * t + 4 * fq) = d;
        }
#pragma unroll
        for (int tau = 0; tau < 16; ++tau) {
            const f32x2 bu = *(const LAS f32x2*)(BU + tau * BU_PITCH + 2 * lane);
            const float nhr = ar * hr - ai * hi_ + bu.x, nhi = ar * hi_ + ai * hr + bu.y;
            hr = nhr; hi_ = nhi;
        }
    }
    SG[(wave * 64 + lane) * 2] = hr; SG[(wave * 64 + lane) * 2 + 1] = hi_;
    __syncthreads();
    {
        float pr = ar, pi = ai;
#pragma unroll
        for (int s = 0; s < 9; ++s) { const float nr = pr * pr - pi * pi, ni = 2.0f * pr * pi; pr = nr; pi = ni; }
        hr = 0.f; hi_ = 0.f;
        for (int w2 = 0; w2 < wave; ++w2) {
            const float sr = SG[(w2 * 64 + lane) * 2], si = SG[(w2 * 64 + lane) * 2 + 1];
            const float nhr = pr * hr - pi * hi_ + sr, nhi = pr * hi_ + pi * hr + si;
            hr = nhr; hi_ = nhi;
        }
    }
    for (int ch = 0; ch < 32; ++ch) {
        bf16x8 uf = (bf16x8){0, 0, 0, 0, 0, 0, 0, 0};
        if (fq < 2) uf = *(const bf16x8*)(ubase + (size_t)(ch * 16 + fr) * INW + 8 * fq);
        float uu[4];
#pragma unroll
        for (int r = 0; r < 4; ++r) uu[r] = bf2f(ubase[(size_t)(ch * 16 + 4 * fq + r) * INW + fr]);
#pragma unroll
        for (int t = 0; t < 8; ++t) {
            const f32x4 d = __builtin_amdgcn_mfma_f32_16x16x32_bf16(bbf[t], uf, (f32x4){0.f, 0.f, 0.f, 0.f}, 0, 0, 0);
            *(LAS f32x4*)(BU + fr * BU_PITCH + 16 * t + 4 * fq) = d;
        }
#pragma unroll
        for (int tau = 0; tau < 16; ++tau) {
            const f32x2 bu = *(const LAS f32x2*)(BU + tau * BU_PITCH + 2 * lane);
            const float nhr = ar * hr - ai * hi_ + bu.x, nhi = ar * hi_ + ai * hr + bu.y;
            hr = nhr; hi_ = nhi;
            *(LAS unsigned*)(HS + tau * HS_PITCH + 2 * lane) = cvt_pk_bf16(hr, hi_);
        }
        f32x4 y = (f32x4){0.f, 0.f, 0.f, 0.f};
#pragma unroll
        for (int s = 0; s < 4; ++s) {
            const bf16x8 hf = *(const LAS bf16x8*)(HS + fr * HS_PITCH + 32 * s + 8 * fq);
            y = __builtin_amdgcn_mfma_f32_16x16x32_bf16(hf, cmf[s], y, 0, 0, 0);
        }
#pragma unroll
        for (int r = 0; r < 4; ++r) {
            const float yy = y[r] + dsk * uu[r];
            const float inner = 0.7978845608028654f * (yy + 0.044715f * yy * yy * yy);
            const float zz = yy * __builtin_amdgcn_rcpf(1.0f + fast_exp2(-2.0f * LOG2E * inner));
            Z[(row0 + ch * 16 + 4 * fq + r) * SW + g * NCH + fr] = (bf16_t)(cvt_pk_bf16(zz, 0.f) & 0xffffu);
        }
    }
    __syncthreads();
}

constexpr int N_PHASES = 2 + 9 * DEPTH;
__global__ void __launch_bounds__(512, 2) fwd_kernel(Args a) {
    extern __shared__ __attribute__((aligned(16))) unsigned char lds_raw[];
    LAS unsigned char* lds = (LAS unsigned char*)lds_raw;
    const int G = gridDim.x;
    volatile LAS unsigned* MISC = (volatile LAS unsigned*)(lds + MISC_OFF);
    if (threadIdx.x < 64) MISC[threadIdx.x] = 0u;
    __syncthreads();
    unsigned* ctl = (unsigned*)(AWS() + WS_CTL);
    XcdBarrier bar; bar.bar = ctl + CW_BAR; bar.x = 0; bar.st = nullptr;
    const int ph_lo = karg_i(0), ph_hi = karg_i(1);
    const bool multi_phase = (ph_hi - ph_lo) > 1;
    if (multi_phase) bar = xcd_barrier_post(ctl + CW_BAR, MISC + 8);
    const int NGW = G * 8;
    float* mod = (float*)(AWS() + WS_MOD);
    bf16_t* XN = (bf16_t*)(AWS() + WS_XN); bf16_t* FM = (bf16_t*)(AWS() + WS_FM); bf16_t* HB = (bf16_t*)(AWS() + WS_H);
    bf16_t* PROJ = (bf16_t*)(AWS() + WS_PROJ); bf16_t* HEADS = (bf16_t*)(AWS() + WS_HEADS); bf16_t* ZB = (bf16_t*)(AWS() + WS_Z);

    for (int ph = ph_lo; ph < ph_hi; ++ph) {
        int tid = threadIdx.x; asm volatile("" : "+v"(tid));
        const int lane = tid & 63, wave = __builtin_amdgcn_readfirstlane(tid >> 6);
        const int gw = blockIdx.x * 8 + wave;
        if (ph == 0) {
#if !defined(NO_P0)
            phase_p0(lds, tid, lane, wave, G);
#endif
        } else if (ph == 1) {
            thin_resid(nullptr, AIN(I_X), nullptr, nullptr, nullptr, AIN(I_PREMIXG), mod + 1 * D, mod + 0 * D, XN, gw, NGW, lane);
        } else {
            const int l = (ph - 2) / 9, sp = (ph - 2) % 9;
            const float* modl = mod + (size_t)l * NB * NMODC;
            if (sp == 0 || sp == 2 || sp == 4 || sp == 6 || sp == 7) {
                unsigned char* ws = AWS();
                const bf16_t* A; const bf16_t* Bt; int N, K; pg8::EpiGen E; E.Z = nullptr; E.bias = nullptr;
                if (sp == 0)      { A = XN; Bt = (const bf16_t*)(ws + WS_WIN) + (size_t)l * INW * D; N = INW; K = D; E.O = PROJ; E.ldc = INW; E.mode = 0; }
                else if (sp == 2) { A = ZB; Bt = (const bf16_t*)(ws + WS_WGLU) + (size_t)l * SW * SW; N = SW; K = SW; E.O = HEADS + AW; E.ldc = D; E.mode = 2; E.Z = ZB; E.bias = AIN(I_BGLU) + (size_t)l * SW; }
                else if (sp == 4) { A = HEADS; Bt = (const bf16_t*)(ws + WS_WOUT) + (size_t)l * D * D; N = D; K = D; E.O = FM; E.ldc = D; E.mode = 0; }
                else if (sp == 6) { A = XN; Bt = (const bf16_t*)(ws + WS_WMI) + (size_t)l * FF * D; N = FF; K = D; E.O = HB; E.ldc = FF; E.mode = 1; }
                else              { A = HB; Bt = (const bf16_t*)(ws + WS_WMO) + (size_t)l * D * FF; N = D; K = FF; E.O = FM; E.ldc = D; E.mode = 0; }
                gemm_call(lds, A, Bt, N, K, E, tid);
            } else if (sp == 1) {
                for (int u = blockIdx.x; u < NB * (SEQ / 128); u += G) {
#if !defined(NO_ATTN)
                    attn_unit(lds, PROJ, HEADS, AIN(I_SINKS) + l * NQH, u / (SEQ / 128), u % (SEQ / 128), tid);
#endif
                }
                SsmParams spp;
                spp.lam_re = AIN(I_LAMRE) + (size_t)l * NGRP * NST; spp.lam_im = AIN(I_LAMIM) + (size_t)l * NGRP * NST; spp.log_dt = AIN(I_LOGDT) + (size_t)l * NGRP;
                spp.b_re = AIN(I_BRE) + (size_t)l * NGRP * NST * NCH; spp.b_im = AIN(I_BIM) + (size_t)l * NGRP * NST * NCH;
                spp.c_re = AIN(I_CRE) + (size_t)l * NGRP * NCH * NST; spp.c_im = AIN(I_CIM) + (size_t)l * NGRP * NCH * NST; spp.d_skip = AIN(I_DSKIP) + (size_t)l * SW;
                for (int u = blockIdx.x; u < NB * NGRP; u += G) {
#if !defined(NO_SSM)
                    ssm_unit(lds, PROJ, ZB, spp, u / NGRP, u % NGRP, tid);
#endif
                }
            } else if (sp == 3) {
                thin_ssm_norm(HEADS, gw, NGW, lane);
            } else if (sp == 5) {
                thin_resid(FM, l == 0 ? AIN(I_X) : AOUT(), AOUT(), modl + 2 * D, AIN(I_POSTMIXG) + (size_t)l * D,
                           AIN(I_PREMLPG) + (size_t)l * D, modl + 4 * D, modl + 3 * D, XN, gw, NGW, lane);
            } else {
                const bool lastl = (l == DEPTH - 1);
                thin_resid(FM, AOUT(), AOUT(), modl + 5 * D, AIN(I_POSTMLPG) + (size_t)l * D,
                           AIN(I_PREMIXG) + (size_t)(lastl ? l : l + 1) * D, modl + (lastl ? 0 : NB * NMODC) + 1 * D, modl + (lastl ? 0 : NB * NMODC) + 0 * D,
                           lastl ? nullptr : XN, gw, NGW, lane);
            }
        }
        if (ph + 1 < ph_hi) {
            if (ph == ph_lo) { asm volatile("s_waitcnt vmcnt(0)" ::: "memory"); __threadfence(); cg::this_grid().sync(); }
            else xcd_barrier(bar);
        }
    }
}

extern "C" void kernel_launch(void* const* d_in, const int* in_sizes, int n_in, void* d_out, int out_size, void* d_ws, size_t ws_size, hipStream_t stream) {
    static int grid = 0;
    if (grid == 0) {
        if (n_in != 25 || out_size != M * D || ws_size < WS_END) { fprintf(stderr, "kernel_launch: unexpected shapes (n_in %d out %d ws %zu)\n", n_in, out_size, ws_size); grid = -1; return; }
        int dev = 0, cus = 0, per_cu = 0;
        hipGetDevice(&dev); hipDeviceGetAttribute(&cus, hipDeviceAttributeMultiprocessorCount, dev);
        if (hipFuncSetAttribute((const void*)fwd_kernel, hipFuncAttributeMaxDynamicSharedMemorySize, LDS_BYTES) != hipSuccess) { fprintf(stderr, "kernel_launch: hipFuncSetAttribute failed\n"); grid = -1; return; }
        hipOccupancyMaxActiveBlocksPerMultiprocessor(&per_cu, (const void*)fwd_kernel, 512, LDS_BYTES);
        (void)hipGetLastError();
        if (per_cu < 1) per_cu = 1;
        grid = cus;
    }
    if (grid < 0) return;
    hipMemsetAsync((char*)d_ws + WS_CTL, 0, CTL_ZERO_BYTES, stream);
    Args a{};
    for (int i = 0; i < 25; ++i) a.in[i] = (const float*)d_in[i];
    a.out = (float*)d_out; a.ws = (unsigned char*)d_ws;
#if MK_MULTI
    for (int ph = 0; ph < N_PHASES; ++ph) {
        a.ph_lo = ph; a.ph_hi = ph + 1;
        hipLaunchKernelGGL(fwd_kernel, dim3(grid), dim3(512), LDS_BYTES, stream, a);
    }
#else
    a.ph_lo = 0; a.ph_hi = N_PHASES;
    void* args[] = {&a};
    hipError_t e = hipLaunchCooperativeKernel((const void*)fwd_kernel, dim3(grid), dim3(512), args, LDS_BYTES, stream);
    if (e != hipSuccess) fprintf(stderr, "cooperative launch failed: %s (grid %d)\n", hipGetErrorString(e), grid);
#endif
}
```

```cpp
#include <hip/hip_runtime.h>
#include <hip/hip_cooperative_groups.h>
#include <cstdio>
#include <cstdint>
namespace cg = cooperative_groups;

#ifndef MK_MULTI
#define MK_MULTI 0
#endif

#define GAS __attribute__((address_space(1)))
#define LAS __attribute__((address_space(3)))
typedef unsigned short bf16_t;
typedef short bf16x8 __attribute__((ext_vector_type(8)));
typedef short s16x4 __attribute__((ext_vector_type(4)));
typedef float f32x4 __attribute__((ext_vector_type(4)));
typedef float f32x2 __attribute__((ext_vector_type(2)));
typedef float f32x16 __attribute__((ext_vector_type(16)));
typedef unsigned u32x4 __attribute__((ext_vector_type(4)));
typedef unsigned u32x2 __attribute__((ext_vector_type(2)));

constexpr int D = 1024, NB = 8, SEQ = 4096, DEPTH = 4, M = NB * SEQ;
constexpr int AW = 512, SW = 512, NQH = 8, FF = 4096, INW = 1280, NMODC = 6 * D;
constexpr int NGRP = 32, NST = 64, NCH = 16;
constexpr float EPS = 1e-6f;
constexpr float LOG2E = 1.4426950408889634f;

constexpr size_t MiB = 1u << 20;
constexpr size_t WS_CTL = 0, CTL_ZERO_BYTES = 64 * 1024;
constexpr size_t WS_MOD = 1 * MiB;
constexpr size_t WS_WIN = 2 * MiB;
constexpr size_t WS_WOUT = 12 * MiB;
constexpr size_t WS_WGLU = 20 * MiB;
constexpr size_t WS_WMI = 22 * MiB;
constexpr size_t WS_WMO = 54 * MiB;
constexpr size_t WS_XN = 88 * MiB;
constexpr size_t WS_FM = 152 * MiB;
constexpr size_t WS_H = 216 * MiB;
constexpr size_t WS_PROJ = 216 * MiB;
constexpr size_t WS_HEADS = 296 * MiB;
constexpr size_t WS_Z = 360 * MiB;
constexpr size_t WS_END = 472 * MiB;
constexpr int CW_BAR = 1024;

constexpr int LDS_BYTES = 153600;
constexpr int MISC_OFF = LDS_BYTES - 256;

__device__ __forceinline__ unsigned cvt_pk_bf16(float lo, float hi) { unsigned r; asm volatile("v_cvt_pk_bf16_f32 %0, %1, %2" : "=v"(r) : "v"(lo), "v"(hi)); return r; }
__device__ __forceinline__ float bf_lo(unsigned w) { return __uint_as_float(w << 16); }
__device__ __forceinline__ float bf_hi(unsigned w) { return __uint_as_float(w & 0xffff0000u); }
__device__ __forceinline__ float bf2f(bf16_t v) { return __uint_as_float(((unsigned)v) << 16); }
__device__ __forceinline__ float wave_sum(float v) {
#pragma unroll
    for (int o = 1; o < 64; o <<= 1) v += __shfl_xor(v, o);
    return v;
}
__device__ __forceinline__ float fast_exp2(float x) { return __builtin_amdgcn_exp2f(x); }
__device__ __forceinline__ float sigmoidf_(float v) { return __builtin_amdgcn_rcpf(1.0f + fast_exp2(-LOG2E * v)); }
#define LDS_WAIT() asm volatile("s_waitcnt lgkmcnt(0)" ::: "memory")

namespace pg8 {
constexpr int BM = 256, BK = 64, HALF = 128, HTB = HALF * BK * 2, STAGE_BYTES = 8 * HTB, NXCD = 8, WGM = 8;
__host__ __device__ __forceinline__ int lds_byte(int r, int c) { const int st = (r >> 4) * 2 + (c >> 5), rr = r & 15, cc = c & 31, ob = rr * 64 + cc * 2; return st * 1024 + (ob ^ (((ob >> 9) & 1) << 5)); }
__host__ __device__ __forceinline__ void stage_rc(int b, int& R, int& C) { const int st = b / 1024, sb = b % 1024, swz = sb ^ (((sb >> 9) & 1) << 5); R = (st >> 1) * 16 + swz / 64; C = (st & 1) * 32 + (swz % 64) / 2; }
__host__ __device__ __forceinline__ int perm32(int rho) { const int n = rho >> 4, i = rho & 15; return 8 * (i >> 2) + 4 * n + (i & 3); }

struct Unit { int pm, pn; };
struct Gemm { const bf16_t* A; const bf16_t* Bt; int M, N, K; };

struct StaticOrder {
    int nM, nN, nwg, G, c;
    __host__ __device__ void init(int M_, int N_, int G_, int c_) { nM = M_ / BM; nN = N_ / BM; nwg = nM * nN; G = G_; c = c_; }
    __host__ __device__ bool next(int i, Unit& u) const {
        const long L = (long)i * G + c; if (L >= nwg) return false;
        int wgid = (int)L; { const int q = nwg / NXCD, r = nwg % NXCD, xcd = wgid % NXCD, off = wgid / NXCD; wgid = (xcd < r ? xcd * (q + 1) : r * (q + 1) + (xcd - r) * q) + off; }
        const int nig = WGM * nN, gid = wgid / nig, fm = gid * WGM, gsz = (nM - fm) < WGM ? (nM - fm) : WGM;
        u.pm = fm + ((wgid % nig) % gsz); u.pn = (wgid % nig) / gsz; return true;
    }
    __device__ __forceinline__ void a_ready(const Unit&) const {}
    __device__ __forceinline__ void done(const Unit&) const {}
};

struct EpiGen {
    static constexpr bool PERM = true, AFTER_DRAIN = false;
    bf16_t* O; int ldc; int mode; const bf16_t* Z; const float* bias;
    __device__ __forceinline__ void operator()(const f32x4 (&acc)[2][2][4][2], const Unit& u, int wr, int wc, int fr, int fq) const {
        const int row0 = u.pm * BM + wr * 64 + fr; const int col0 = u.pn * BM + wc * 32 + 8 * fq;
#pragma unroll
        for (int ai = 0; ai < 2; ++ai)
#pragma unroll
            for (int m = 0; m < 4; ++m) {
                const size_t row = (size_t)(row0 + ai * HALF + m * 16);
#pragma unroll
                for (int bj = 0; bj < 2; ++bj) {
                    const int col = col0 + bj * HALF;
                    f32x4 v0 = acc[ai][bj][m][0], v1 = acc[ai][bj][m][1];
                    if (mode == 1) {
#pragma unroll
                        for (int j = 0; j < 4; ++j) { const float a = fmaxf(v0[j], 0.f), b = fmaxf(v1[j], 0.f); v0[j] = a * a; v1[j] = b * b; }
                    } else if (mode == 2) {
                        const u32x4 zz = *(const u32x4*)(Z + row * 512 + col);
                        const f32x4 b0 = *(const f32x4*)(bias + col), b1 = *(const f32x4*)(bias + col + 4);
                        v0[0] = bf_lo(zz.x) * sigmoidf_(v0[0] + b0[0]); v0[1] = bf_hi(zz.x) * sigmoidf_(v0[1] + b0[1]);
                        v0[2] = bf_lo(zz.y) * sigmoidf_(v0[2] + b0[2]); v0[3] = bf_hi(zz.y) * sigmoidf_(v0[3] + b0[3]);
                        v1[0] = bf_lo(zz.z) * sigmoidf_(v1[0] + b1[0]); v1[1] = bf_hi(zz.z) * sigmoidf_(v1[1] + b1[1]);
                        v1[2] = bf_lo(zz.w) * sigmoidf_(v1[2] + b1[2]); v1[3] = bf_hi(zz.w) * sigmoidf_(v1[3] + b1[3]);
                    }
                    u32x4 w; w.x = cvt_pk_bf16(v0[0], v0[1]); w.y = cvt_pk_bf16(v0[2], v0[3]); w.z = cvt_pk_bf16(v1[0], v1[1]); w.w = cvt_pk_bf16(v1[2], v1[3]);
                    *(u32x4*)(O + row * ldc + col) = w;
                }
            }
    }
};

template <class Epi, class Sched, bool ALIGN_EPI = false, bool SP2 = false>
__device__ __forceinline__ void gemm_phase(LAS unsigned char* lds, const Gemm g, const Sched& S, const Epi& E, const int tid) {
    const int wid = __builtin_amdgcn_readfirstlane(tid >> 6), lane = tid & 63, wr = wid >> 2, wc = wid & 3, fr = lane & 15, fq = lane >> 4;
    const int K = g.K, nt = K / BK;
    unsigned voffA[2], voffB[2];
#pragma unroll
    for (int i = 0; i < 2; ++i) { int R, C; stage_rc(tid * 16 + i * 8192, R, C); const int Rb = Epi::PERM ? ((R & ~31) + perm32(R & 31)) : R;
        voffA[i] = (unsigned)(R * K + C) * 2u; voffB[i] = (unsigned)(Rb * K + C) * 2u; }
    const size_t kstep = (size_t)(BK * 2);
    const size_t hstep = (size_t)HALF * K * 2;
    const size_t tstep = 2 * hstep;
    const unsigned ldsw = (unsigned)wid * 1024u;
    const int aoff = lds_byte(wr * 64 + fr, fq * 8), boff = lds_byte(wc * 32 + fr, fq * 8);
#define PG8_SA(b, h) (((b) * 2 + (h)) * HTB)
#define PG8_SB(b, h) ((4 + (b) * 2 + (h)) * HTB)
#define PG8_STAGE(bufoff, gbase, voff) do { _Pragma("unroll") for (int _i = 0; _i < 2; ++_i) \
        __builtin_amdgcn_global_load_lds((const unsigned*)((const char*)(gbase) + (voff)[_i]), (LAS unsigned*)(lds + (bufoff) + ldsw + _i * 8192), 16, 0, 0); } while (0)
#define PG8_LDA(dst, b, h) do { _Pragma("unroll") for (int m = 0; m < 4; ++m) _Pragma("unroll") for (int k = 0; k < 2; ++k) dst[m][k] = *(const LAS bf16x8*)(lds + PG8_SA(b, h) + aoff + m * 2048 + k * 1024); } while (0)
#define PG8_LDB(dst, b, h) do { _Pragma("unroll") for (int n = 0; n < 2; ++n) _Pragma("unroll") for (int k = 0; k < 2; ++k) dst[n][k] = *(const LAS bf16x8*)(lds + PG8_SB(b, h) + boff + n * 2048 + k * 1024); } while (0)
#define PG8_MMA(ai, bj, At, Bt) do { __builtin_amdgcn_s_setprio(1); _Pragma("unroll") for (int m = 0; m < 4; ++m) _Pragma("unroll") for (int n = 0; n < 2; ++n) _Pragma("unroll") for (int k = 0; k < 2; ++k) \
        acc[ai][bj][m][n] = __builtin_amdgcn_mfma_f32_16x16x32_bf16(Bt[n][k], At[m][k], acc[ai][bj][m][n], 0, 0, 0); __builtin_amdgcn_s_setprio(0); } while (0)
#define PG8_WAIT_V(n) asm volatile("s_waitcnt vmcnt(" #n ")" ::: "memory")
#define PG8_WAIT_L(n) asm volatile("s_waitcnt lgkmcnt(" #n ")" ::: "memory")
#define PG8_BAR __builtin_amdgcn_s_barrier()
#define PG8_SCHED __builtin_amdgcn_sched_barrier(0)
    Unit cur, nxt; int ui = 0;
    if (!S.next(0, cur)) return;
    f32x4 acc[2][2][4][2];
#pragma unroll
    for (int a = 0; a < 2; ++a)
#pragma unroll
        for (int b = 0; b < 2; ++b)
#pragma unroll
            for (int m = 0; m < 4; ++m)
#pragma unroll
                for (int n = 0; n < 2; ++n) acc[a][b][m][n] = (f32x4){0.f, 0.f, 0.f, 0.f};
    bf16x8 At[4][2], B0[2][2], B1[2][2];
    const char* cA = (const char*)g.A + (size_t)cur.pm * tstep; const char* cB = (const char*)g.Bt + (size_t)cur.pn * tstep;
    S.a_ready(cur);
    if constexpr (SP2) {
        PG8_STAGE(PG8_SB(0, 0), cB, voffB); PG8_STAGE(PG8_SB(0, 1), cB + hstep, voffB); PG8_STAGE(PG8_SA(0, 0), cA, voffA); PG8_STAGE(PG8_SA(0, 1), cA + hstep, voffA);
        if (wr == 1) PG8_BAR;
        PG8_WAIT_V(2); PG8_BAR;
        PG8_STAGE(PG8_SB(1, 0), cB + kstep, voffB); PG8_STAGE(PG8_SA(1, 0), cA + kstep, voffA); PG8_STAGE(PG8_SB(1, 1), cB + hstep + kstep, voffB);
        PG8_WAIT_V(6); PG8_BAR;
    } else {
        PG8_STAGE(PG8_SB(0, 0), cB, voffB); PG8_STAGE(PG8_SA(0, 0), cA, voffA); PG8_STAGE(PG8_SB(0, 1), cB + hstep, voffB); PG8_STAGE(PG8_SA(0, 1), cA + hstep, voffA);
        if (wr == 1) PG8_BAR;
        PG8_WAIT_V(4); PG8_BAR;
        PG8_STAGE(PG8_SB(1, 0), cB + kstep, voffB); PG8_STAGE(PG8_SA(1, 0), cA + kstep, voffA); PG8_STAGE(PG8_SB(1, 1), cB + hstep + kstep, voffB);
        PG8_WAIT_V(6); PG8_BAR;
    }
    for (;;) {
        const bool has_next = S.next(ui + 1, nxt);
        const char* nA = has_next ? (const char*)g.A + (size_t)nxt.pm * tstep : cA; const char* nB = has_next ? (const char*)g.Bt + (size_t)nxt.pn * tstep : cB;
        for (int t = 0; t < nt; t += 2) {
            const bool last = (t == nt - 2);
            const char* a1 = cA + (size_t)(t + 1) * kstep;
            const char* a2 = last ? nA : cA + (size_t)(t + 2) * kstep; const char* b2 = last ? nB : cB + (size_t)(t + 2) * kstep;
            const char* a3 = a2 + kstep; const char* b3 = b2 + kstep;
            if (last && has_next) S.a_ready(nxt);
            if constexpr (SP2) {
            PG8_LDB(B0, 0, 0); PG8_LDB(B1, 0, 1); PG8_SCHED; PG8_LDA(At, 0, 0); PG8_STAGE(PG8_SA(1, 1), a1 + hstep, voffA);
            PG8_WAIT_V(8); PG8_WAIT_L(0); PG8_BAR; PG8_MMA(0, 0, At, B0); PG8_MMA(0, 1, At, B1); PG8_BAR; PG8_SCHED;
            PG8_LDA(At, 0, 1); PG8_STAGE(PG8_SB(0, 0), b2, voffB); PG8_STAGE(PG8_SB(0, 1), b2 + hstep, voffB); PG8_STAGE(PG8_SA(0, 0), a2, voffA);
            PG8_WAIT_V(8); PG8_WAIT_L(0); PG8_BAR; PG8_MMA(1, 0, At, B0); PG8_MMA(1, 1, At, B1); PG8_BAR; PG8_SCHED;
            PG8_LDB(B0, 1, 0); PG8_LDB(B1, 1, 1); PG8_SCHED; PG8_LDA(At, 1, 0); PG8_STAGE(PG8_SA(0, 1), a2 + hstep, voffA);
            PG8_WAIT_V(8); PG8_WAIT_L(0); PG8_BAR; PG8_MMA(0, 0, At, B0); PG8_MMA(0, 1, At, B1); PG8_BAR; PG8_SCHED;
            PG8_LDA(At, 1, 1); PG8_STAGE(PG8_SB(1, 0), b3, voffB); PG8_STAGE(PG8_SB(1, 1), b3 + hstep, voffB); PG8_STAGE(PG8_SA(1, 0), a3, voffA);
            PG8_WAIT_V(8); PG8_WAIT_L(0); PG8_BAR; PG8_MMA(1, 0, At, B0); PG8_MMA(1, 1, At, B1); PG8_BAR; PG8_SCHED;
            } else {
            PG8_LDB(B0, 0, 0); PG8_SCHED; PG8_LDA(At, 0, 0); PG8_STAGE(PG8_SA(1, 1), a1 + hstep, voffA);
            PG8_WAIT_L(8); PG8_BAR; PG8_WAIT_L(0); PG8_MMA(0, 0, At, B0); PG8_BAR; PG8_SCHED;
            PG8_LDB(B1, 0, 1); PG8_STAGE(PG8_SB(0, 0), b2, voffB);
            PG8_BAR; PG8_WAIT_L(0); PG8_MMA(0, 1, At, B1); PG8_BAR;
            PG8_LDA(At, 0, 1); PG8_STAGE(PG8_SA(0, 0), a2, voffA);
            PG8_BAR; PG8_WAIT_L(0); PG8_MMA(1, 0, At, B0); PG8_BAR; PG8_SCHED;
            PG8_STAGE(PG8_SB(0, 1), b2 + hstep, voffB);
            PG8_WAIT_V(6); PG8_BAR; PG8_MMA(1, 1, At, B1); PG8_BAR;
            PG8_LDB(B0, 1, 0); PG8_SCHED; PG8_LDA(At, 1, 0); PG8_STAGE(PG8_SA(0, 1), a2 + hstep, voffA);
            PG8_WAIT_L(8); PG8_BAR; PG8_WAIT_L(0); PG8_MMA(0, 0, At, B0); PG8_BAR; PG8_SCHED;
            PG8_LDB(B1, 1, 1); PG8_STAGE(PG8_SB(1, 0), b3, voffB);
            PG8_BAR; PG8_WAIT_L(0); PG8_MMA(0, 1, At, B1); PG8_BAR;
            PG8_LDA(At, 1, 1); PG8_STAGE(PG8_SA(1, 0), a3, voffA);
            PG8_BAR; PG8_WAIT_L(0); PG8_MMA(1, 0, At, B0); PG8_BAR; PG8_SCHED;
            PG8_STAGE(PG8_SB(1, 1), b3 + hstep, voffB);
            PG8_WAIT_V(6); PG8_BAR; PG8_MMA(1, 1, At, B1); PG8_BAR;
            }
        }
        if constexpr (ALIGN_EPI) { if (wr == 0) PG8_BAR; }
        if constexpr (!Epi::AFTER_DRAIN) { E(acc, cur, wr, wc, fr, fq); S.done(cur); }
        if (!has_next) break;
#pragma unroll
        for (int a = 0; a < 2; ++a)
#pragma unroll
            for (int b = 0; b < 2; ++b)
#pragma unroll
                for (int m = 0; m < 4; ++m)
#pragma unroll
                    for (int n = 0; n < 2; ++n) acc[a][b][m][n] = (f32x4){0.f, 0.f, 0.f, 0.f};
        cur = nxt; cA = nA; cB = nB; ++ui;
        if constexpr (ALIGN_EPI) { if (wr == 1) PG8_BAR; }
    }
    PG8_WAIT_V(0);
    if constexpr (!ALIGN_EPI) { if (wr == 0) PG8_BAR; }
    PG8_BAR;
#undef PG8_SA
#undef PG8_SB
#undef PG8_STAGE
#undef PG8_LDA
#undef PG8_LDB
#undef PG8_MMA
#undef PG8_WAIT_V
#undef PG8_WAIT_L
#undef PG8_BAR
#undef PG8_SCHED
}
}

__device__ __forceinline__ void gemm_call(LAS unsigned char* lds, const bf16_t* A, const bf16_t* Bt, int N, int K, const pg8::EpiGen& E, int tid) {
#if !defined(NO_GEMM)
    pg8::Gemm g{A, Bt, M, N, K};
    pg8::StaticOrder S; S.init(M, N, (int)gridDim.x, (int)blockIdx.x);
    pg8::gemm_phase<pg8::EpiGen, pg8::StaticOrder, true, true>(lds, g, S, E, tid);
#endif
}

#define XB_TMO      128
#define XB_XCNT(j)  (256  + 64 * (j))
#define XB_XSUB(j)  (1280 + 64 * (j))
#define XB_XGEN(j)  (2304 + 64 * (j))
#define XB_TOP      3328
#define XB_TOPGEN   3392
#define XCD_BAR_WORDS 3456
#define XB_SPIN_CAP (1u << 20)
__device__ __forceinline__ unsigned xb_ld(unsigned* p)              { return __hip_atomic_load(p, __ATOMIC_RELAXED, __HIP_MEMORY_SCOPE_AGENT); }
__device__ __forceinline__ unsigned xb_add(unsigned* p, unsigned v) { return __hip_atomic_fetch_add(p, v, __ATOMIC_RELAXED, __HIP_MEMORY_SCOPE_AGENT); }
__device__ __forceinline__ unsigned xb_xcc_id() { return (unsigned)__builtin_amdgcn_s_getreg((3 << 11) | 20) & 0xFu; }
#define XB_SPIN(cond, bar) do { unsigned _sp = 0; while (cond) { __builtin_amdgcn_s_sleep(1); \
    if ((++_sp & 255u) == 0u) { if (xb_ld(&(bar)[XB_TMO])) break; if (_sp > XB_SPIN_CAP) { atomicAdd(&(bar)[XB_TMO], 1u); break; } } } } while (0)
struct XcdBarrier { unsigned* bar; unsigned x; volatile LAS unsigned* st; };
__device__ __forceinline__ XcdBarrier xcd_barrier_post(unsigned* bar, volatile LAS unsigned* st) {
    XcdBarrier b; b.bar = bar; b.x = xb_xcc_id(); b.st = st;
    if (threadIdx.x == 0) (void)xb_add(&bar[XB_XCNT(b.x)], 1u);
    return b;
}
__device__ __forceinline__ void xcd_barrier_complete(unsigned* bar, unsigned x, unsigned& nloc, unsigned& nx) {
    const unsigned G = gridDim.x * gridDim.y * gridDim.z;
    unsigned sum, cnt, mine, sp = 0u;
    for (;;) {
        sum = 0u; cnt = 0u; mine = 0u;
#pragma unroll
        for (unsigned j = 0; j < 16; ++j) { const unsigned c = xb_ld(&bar[XB_XCNT(j)]); sum += c; cnt += (c > 0u) ? 1u : 0u; mine = (j == x) ? c : mine; }
        if (sum == G) break;
        __builtin_amdgcn_s_sleep(1);
        if ((++sp & 255u) == 0u) { if (xb_ld(&bar[XB_TMO])) break; if (sp > XB_SPIN_CAP) { atomicAdd(&bar[XB_TMO], 1u); break; } }
    }
    nloc = mine > 0u ? mine : 1u; nx = cnt > 0u ? cnt : 1u;
}
__device__ __forceinline__ void xcd_barrier(const XcdBarrier& b) {
    asm volatile("s_waitcnt vmcnt(0)" ::: "memory");
    __syncthreads();
    if (threadIdx.x == 0) {
        unsigned* bar = b.bar;
        __builtin_amdgcn_s_waitcnt(0);
        unsigned nloc = b.st[0], nx = b.st[1];
        if (nloc == 0u) { xcd_barrier_complete(bar, b.x, nloc, nx); b.st[0] = nloc; b.st[1] = nx; }
        const unsigned old = xb_add(&bar[XB_XSUB(b.x)], 1u);
        const unsigned gen = old / nloc;
        if (old + 1u == (gen + 1u) * nloc) {
            __builtin_amdgcn_fence(__ATOMIC_RELEASE, "agent");
            asm volatile("s_waitcnt vmcnt(0)" ::: "memory");
            const unsigned og = xb_add(&bar[XB_TOP], 1u);
            const unsigned tg = og / nx;
            if (og + 1u == (tg + 1u) * nx) xb_add(&bar[XB_TOPGEN], 1u);
            else XB_SPIN(xb_ld(&bar[XB_TOPGEN]) == tg, bar);
            __builtin_amdgcn_fence(__ATOMIC_ACQUIRE, "agent");
            xb_add(&bar[XB_XGEN(b.x)], 1u);
            asm volatile("s_waitcnt vmcnt(0)" ::: "memory");
        } else {
            XB_SPIN(xb_ld(&bar[XB_XGEN(b.x)]) == gen, bar);
            __builtin_amdgcn_fence(__ATOMIC_ACQUIRE, "agent");
            asm volatile("s_waitcnt vmcnt(0)" ::: "memory");
        }
    }
    __syncthreads();
}

struct Args {
    const float* in[25];
    float* out; unsigned char* ws;
    int ph_lo, ph_hi;
};
enum { I_X = 0, I_C, I_WADA, I_BADA, I_PREMIXG, I_WIN, I_SINKS, I_LAMRE, I_LAMIM, I_LOGDT, I_BRE, I_BIM, I_CRE, I_CIM, I_DSKIP, I_WGLU, I_BGLU,
       I_ATTNG, I_SSMG, I_WOUT, I_POSTMIXG, I_PREMLPG, I_WMI, I_WMO, I_POSTMLPG };

typedef const unsigned char __attribute__((address_space(4)))* kargp_t;
__device__ __forceinline__ const float* karg_in(int i) {
    kargp_t kp = (kargp_t)__builtin_amdgcn_kernarg_segment_ptr();
    asm volatile("" : "+s"(kp));
    return *(const float* const __attribute__((address_space(4)))*)(kp + 8 * i);
}
__device__ __forceinline__ float* karg_out() { kargp_t kp = (kargp_t)__builtin_amdgcn_kernarg_segment_ptr(); asm volatile("" : "+s"(kp)); return *(float* const __attribute__((address_space(4)))*)(kp + 8 * 25); }
__device__ __forceinline__ unsigned char* karg_ws() { kargp_t kp = (kargp_t)__builtin_amdgcn_kernarg_segment_ptr(); asm volatile("" : "+s"(kp)); return *(unsigned char* const __attribute__((address_space(4)))*)(kp + 8 * 26); }
__device__ __forceinline__ int karg_i(int i) { kargp_t kp = (kargp_t)__builtin_amdgcn_kernarg_segment_ptr(); asm volatile("" : "+s"(kp)); return *(const int __attribute__((address_space(4)))*)(kp + 8 * 27 + 4 * i); }
#define AIN(i) karg_in(i)
#define AWS() karg_ws()
#define AOUT() karg_out()

__device__ __forceinline__ void p0_transpose_item(const float* W, int K, int N, bf16_t* WT, const float* kscale, LAS float* scr, int item, int lane) {
    const int nblk = N / 32, kb = item / nblk, nb = item % nblk, k0 = 64 * kb, n0 = 32 * nb;
#pragma unroll 8
    for (int i = 0; i < 32; ++i) { const int kk = 2 * i + (lane >> 5); float v = W[(size_t)(k0 + kk) * N + n0 + (lane & 31)]; if (kscale) v *= kscale[k0 + kk]; scr[kk * 33 + (lane & 31)] = v; }
    LDS_WAIT(); asm volatile("" ::: "memory");
    const int c = lane & 7;
#pragma unroll
    for (int j = 0; j < 4; ++j) { const int n = (lane >> 3) + 8 * j; const LAS float* s = scr + (8 * c) * 33 + n;
        u32x4 o; o.x = cvt_pk_bf16(s[0 * 33], s[1 * 33]); o.y = cvt_pk_bf16(s[2 * 33], s[3 * 33]); o.z = cvt_pk_bf16(s[4 * 33], s[5 * 33]); o.w = cvt_pk_bf16(s[6 * 33], s[7 * 33]);
        *(u32x4*)(WT + (size_t)(n0 + n) * K + k0 + 8 * c) = o; }
    LDS_WAIT(); asm volatile("" ::: "memory");
}

__device__ __forceinline__ void phase_p0(LAS unsigned char* lds, int tid, int lane, int wave, int G) {
    LAS float* cact = (LAS float*)(lds + 67584);
    LAS float* red = (LAS float*)(lds + 100352);
    float* mod = (float*)(AWS() + WS_MOD);
    {
        const float* c = AIN(I_C);
        for (int e = tid; e < NB * D; e += 512) { const float v = c[e]; cact[e] = v / (1.0f + __expf(-v)); }
        __syncthreads();
        for (int item = blockIdx.x; item < DEPTH * (NMODC / 64); item += G) {
            const int l = item / (NMODC / 64), cb = item % (NMODC / 64), col = cb * 64 + lane;
            const float* w = AIN(I_WADA) + (size_t)l * D * NMODC + col;
            float acc[8];
#pragma unroll
            for (int b = 0; b < 8; ++b) acc[b] = 0.f;
            const int k0 = wave * 128;
#pragma unroll 4
            for (int k = k0; k < k0 + 128; ++k) {
                const float wv = w[(size_t)k * NMODC];
#pragma unroll
                for (int b = 0; b < 8; ++b) acc[b] += wv * cact[b * D + k];
            }
#pragma unroll
            for (int b = 0; b < 8; ++b) red[(wave * 8 + b) * 64 + lane] = acc[b];
            __syncthreads();
            {
                const int b = wave; float s = 0.f;
#pragma unroll
                for (int w8 = 0; w8 < 8; ++w8) s += red[(w8 * 8 + b) * 64 + lane];
                mod[((size_t)l * NB + b) * NMODC + col] = s + AIN(I_BADA)[(size_t)l * NMODC + col];
            }
            __syncthreads();
        }
    }
    LAS float* scr = (LAS float*)(lds + wave * 8448);
    const int gw = blockIdx.x * 8 + wave, NGW = G * 8;
    constexpr int I_IN = (D / 64) * (INW / 32), I_OUT = (D / 64) * (D / 32), I_GLU = (SW / 64) * (SW / 32), I_MI = (D / 64) * (FF / 32), I_MO = (FF / 64) * (D / 32);
    constexpr int PER_L = I_IN + I_OUT + I_GLU + I_MI + I_MO;
    for (int it = gw; it < DEPTH * PER_L; it += NGW) {
        const int l = it / PER_L; int r = it % PER_L;
        if (r < I_IN) { p0_transpose_item(AIN(I_WIN) + (size_t)l * D * INW, D, INW, (bf16_t*)(AWS() + WS_WIN) + (size_t)l * INW * D, nullptr, scr, r, lane); continue; } r -= I_IN;
        if (r < I_OUT) {
            const int kb = r / (D / 32); const float* ks = (kb * 64 < AW) ? (AIN(I_ATTNG) + (size_t)l * AW) : (AIN(I_SSMG) + (size_t)l * SW - AW);
            p0_transpose_item(AIN(I_WOUT) + (size_t)l * D * D, D, D, (bf16_t*)(AWS() + WS_WOUT) + (size_t)l * D * D, ks, scr, r, lane); continue; } r -= I_OUT;
        if (r < I_GLU) { p0_transpose_item(AIN(I_WGLU) + (size_t)l * SW * SW, SW, SW, (bf16_t*)(AWS() + WS_WGLU) + (size_t)l * SW * SW, nullptr, scr, r, lane); continue; } r -= I_GLU;
        if (r < I_MI) { p0_transpose_item(AIN(I_WMI) + (size_t)l * D * FF, D, FF, (bf16_t*)(AWS() + WS_WMI) + (size_t)l * FF * D, nullptr, scr, r, lane); continue; } r -= I_MI;
        p0_transpose_item(AIN(I_WMO) + (size_t)l * FF * D, FF, D, (bf16_t*)(AWS() + WS_WMO) + (size_t)l * D * FF, nullptr, scr, r, lane);
    }
}

__device__ __forceinline__ void thin_resid(const bf16_t* src, const float* xs, float* xd, const float* gate, const float* pg,
                                           const float* ng, const float* nsc, const float* nsh, bf16_t* xn, int gw, int NGW, int lane) {
    for (int m = gw; m < M; m += NGW) {
        const int b = m >> 12;
        f32x4 xv[4];
#pragma unroll
        for (int j = 0; j < 4; ++j) xv[j] = ((const f32x4*)(xs + (size_t)m * D))[lane + 64 * j];
        if (src) {
            f32x4 f[4]; float ss = 0.f;
#pragma unroll
            for (int j = 0; j < 4; ++j) { const u32x2 w = ((const u32x2*)(src + (size_t)m * D))[lane + 64 * j];
                f[j] = (f32x4){bf_lo(w.x), bf_hi(w.x), bf_lo(w.y), bf_hi(w.y)}; ss += (f[j].x * f[j].x + f[j].y * f[j].y) + (f[j].z * f[j].z + f[j].w * f[j].w); }
            const float rstd = rsqrtf(wave_sum(ss) * (1.0f / D) + EPS);
#pragma unroll
            for (int j = 0; j < 4; ++j) { const int col = 4 * (lane + 64 * j);
                const f32x4 gt = *(const f32x4*)(gate + (size_t)b * NMODC + col), pgv = *(const f32x4*)(pg + col);
                xv[j] += gt * pgv * (f[j] * rstd);
                ((f32x4*)(xd + (size_t)m * D))[lane + 64 * j] = xv[j]; }
        }
        if (xn) {
            float ss = 0.f;
#pragma unroll
            for (int j = 0; j < 4; ++j) ss += (xv[j].x * xv[j].x + xv[j].y * xv[j].y) + (xv[j].z * xv[j].z + xv[j].w * xv[j].w);
            const float rstd = rsqrtf(wave_sum(ss) * (1.0f / D) + EPS);
#pragma unroll
            for (int j = 0; j < 4; ++j) { const int col = 4 * (lane + 64 * j);
                const f32x4 g = *(const f32x4*)(ng + col), sc = *(const f32x4*)(nsc + (size_t)b * NMODC + col), sh = *(const f32x4*)(nsh + (size_t)b * NMODC + col);
                const f32x4 h = xv[j] * rstd * g * (1.0f + sc) + sh;
                u32x2 w; w.x = cvt_pk_bf16(h.x, h.y); w.y = cvt_pk_bf16(h.z, h.w);
                ((u32x2*)(xn + (size_t)m * D))[lane + 64 * j] = w; }
        }
    }
}
__device__ __forceinline__ void thin_ssm_norm(bf16_t* heads, int gw, int NGW, int lane) {
    for (int m = gw; m < M; m += NGW) {
        u32x4* p = (u32x4*)(heads + (size_t)m * D + AW) + lane;
        const u32x4 w = *p;
        float v[8] = {bf_lo(w.x), bf_hi(w.x), bf_lo(w.y), bf_hi(w.y), bf_lo(w.z), bf_hi(w.z), bf_lo(w.w), bf_hi(w.w)};
        float ss = 0.f;
#pragma unroll
        for (int i = 0; i < 8; ++i) ss += v[i] * v[i];
        const float rstd = rsqrtf(wave_sum(ss) * (1.0f / SW) + EPS);
        u32x4 o; o.x = cvt_pk_bf16(v[0] * rstd, v[1] * rstd); o.y = cvt_pk_bf16(v[2] * rstd, v[3] * rstd); o.z = cvt_pk_bf16(v[4] * rstd, v[5] * rstd); o.w = cvt_pk_bf16(v[6] * rstd, v[7] * rstd);
        *p = o;
    }
}

__device__ __forceinline__ int crow(int r, int hi) { return (r & 3) + 8 * (r >> 2) + 4 * hi; }
constexpr int KS_PITCH = 72, VT_PITCH = 260;
constexpr int ATT_VT_OFF = 2 * 256 * KS_PITCH * 2;
constexpr int ATT_SSQ_OFF = ATT_VT_OFF + 2 * 64 * VT_PITCH * 2;
__device__ __forceinline__ void attn_unit(LAS unsigned char* lds, const bf16_t* PROJ, bf16_t* HEADS, const float* sinks, int b, int n, int tid) {
    const int lane = tid & 63, wave = __builtin_amdgcn_readfirstlane(tid >> 6), r32 = lane & 31, hi = lane >> 5;
    LAS bf16_t* Ks = (LAS bf16_t*)lds;
    LAS bf16_t* VT = (LAS bf16_t*)(lds + ATT_VT_OFF);
    LAS float* SSQ = (LAS float*)(lds + ATT_SSQ_OFF);
    const long rowq0 = (long)b * SEQ + n * 128;
    const long rowk0 = rowq0 - 128;
#pragma unroll
    for (int i = 0; i < 8; ++i) {
        const int id = i * 512 + tid, key = id >> 4, rem = id & 15, kvh = rem >> 3, pc = rem & 7;
        u32x4 v = (u32x4){0u, 0u, 0u, 0u};
        if (n > 0 || key >= 128) v = *(const u32x4*)(PROJ + (size_t)(rowk0 + key) * INW + 512 + kvh * 64 + pc * 8);
        *(LAS u32x4*)(Ks + (kvh * 256 + key) * KS_PITCH + pc * 8) = v;
    }
    {
        const int kp = lane & 15, q = lane >> 4, key0 = wave * 32 + 2 * kp;
#pragma unroll
        for (int kvh = 0; kvh < 2; ++kvh)
#pragma unroll
            for (int ph = 0; ph < 2; ++ph) {
                const int pc = q + 4 * ph;
                u32x4 va = (u32x4){0u, 0u, 0u, 0u}, vc = (u32x4){0u, 0u, 0u, 0u};
                if (n > 0 || key0 >= 128) {
                    va = *(const u32x4*)(PROJ + (size_t)(rowk0 + key0) * INW + 640 + kvh * 64 + pc * 8);
                    vc = *(const u32x4*)(PROJ + (size_t)(rowk0 + key0 + 1) * INW + 640 + kvh * 64 + pc * 8);
                }
                LAS bf16_t* dst = VT + (kvh * 64 + pc * 8) * VT_PITCH + key0;
#pragma unroll
                for (int t = 0; t < 4; ++t) {
                    const unsigned wa = va[t], wc = vc[t];
                    *(LAS unsigned*)(dst + (2 * t) * VT_PITCH) = (wa & 0xffffu) | (wc << 16);
                    *(LAS unsigned*)(dst + (2 * t + 1) * VT_PITCH) = (wa >> 16) | (wc & 0xffff0000u);
                }
            }
    }
    __syncthreads();
    const int h = wave, kvh = h >> 2;
    const float slope2 = exp2f(-(float)(h + 1)) * LOG2E;
    const float sink2 = sinks[h] * LOG2E;
    const float sc2 = 0.125f * LOG2E;
    for (int i = 0; i < 4; ++i) {
        bf16x8 qf[4];
#pragma unroll
        for (int dd = 0; dd < 4; ++dd) qf[dd] = *(const bf16x8*)(PROJ + (size_t)(rowq0 + 32 * i + r32) * INW + h * 64 + dd * 16 + hi * 8);
        f32x16 s[5];
#pragma unroll
        for (int kt = 0; kt < 5; ++kt) {
#pragma unroll
            for (int r = 0; r < 16; ++r) s[kt][r] = 0.f;
#pragma unroll
            for (int dd = 0; dd < 4; ++dd) {
                const bf16x8 kf = *(const LAS bf16x8*)(Ks + (kvh * 256 + 32 * (i + kt) + r32) * KS_PITCH + dd * 16 + hi * 8);
                s[kt] = __builtin_amdgcn_mfma_f32_32x32x16_bf16(kf, qf[dd], s[kt], 0, 0, 0);
            }
        }
        float mx = sink2;
        int r32v = r32; asm volatile("" : "+v"(r32v));
        const float fbase = (float)(128 + r32v - 4 * hi);
#pragma unroll
        for (int kt = 0; kt < 5; ++kt) {
            const bool tile_ok = (n > 0) || (i + kt >= 4);
#pragma unroll
            for (int r = 0; r < 16; ++r) {
                const int c0 = (r & 3) + 8 * (r >> 2);
                const float diff = fbase - (float)(32 * kt + c0);
                bool valid = tile_ok;
                if (kt == 0) valid = valid && (diff < 128.0f);
                if (kt == 4) valid = valid && (diff >= 0.0f);
                float v = s[kt][r] * sc2 - slope2 * diff;
                v = valid ? v : -1e30f;
                s[kt][r] = v; mx = fmaxf(mx, v);
            }
        }
        mx = fmaxf(mx, __shfl_xor(mx, 32));
        float lsum = 0.f;
#pragma unroll
        for (int kt = 0; kt < 5; ++kt)
#pragma unroll
            for (int r = 0; r < 16; ++r) { const float p = fast_exp2(s[kt][r] - mx); s[kt][r] = p; lsum += p; }
        lsum += __shfl_xor(lsum, 32);
        lsum += fast_exp2(sink2 - mx);
        const float linv = 1.0f / lsum;
        f32x16 o[2];
#pragma unroll
        for (int r = 0; r < 16; ++r) { o[0][r] = 0.f; o[1][r] = 0.f; }
#pragma unroll
        for (int kt = 0; kt < 5; ++kt)
#pragma unroll
            for (int kk = 0; kk < 2; ++kk) {
                u32x4 pw;
                pw.x = cvt_pk_bf16(s[kt][8 * kk + 0], s[kt][8 * kk + 1]); pw.y = cvt_pk_bf16(s[kt][8 * kk + 2], s[kt][8 * kk + 3]);
                pw.z = cvt_pk_bf16(s[kt][8 * kk + 4], s[kt][8 * kk + 5]); pw.w = cvt_pk_bf16(s[kt][8 * kk + 6], s[kt][8 * kk + 7]);
                const bf16x8 pa = __builtin_bit_cast(bf16x8, pw);
                const int kbase = 32 * (i + kt) + 16 * kk + 4 * hi;
#pragma unroll
                for (int dt = 0; dt < 2; ++dt) {
                    const LAS bf16_t* vp = VT + (kvh * 64 + 32 * dt + r32) * VT_PITCH + kbase;
                    const s16x4 lo = *(const LAS s16x4*)vp, hi4 = *(const LAS s16x4*)(vp + 8);
                    const bf16x8 vb = (bf16x8){lo[0], lo[1], lo[2], lo[3], hi4[0], hi4[1], hi4[2], hi4[3]};
                    o[dt] = __builtin_amdgcn_mfma_f32_32x32x16_bf16(pa, vb, o[dt], 0, 0, 0);
                }
            }
#pragma unroll
        for (int r = 0; r < 16; ++r) {
            const float li = __shfl(linv, crow(r, hi));
            o[0][r] *= li; o[1][r] *= li;
            float q = o[0][r] * o[0][r] + o[1][r] * o[1][r];
            q += __shfl_xor(q, 1); q += __shfl_xor(q, 2); q += __shfl_xor(q, 4); q += __shfl_xor(q, 8); q += __shfl_xor(q, 16);
            if (r32 == 0) SSQ[(32 * i + crow(r, hi)) * 8 + h] = q;
        }
        __syncthreads();
#pragma unroll
        for (int r = 0; r < 16; ++r) {
            const int qrow = 32 * i + crow(r, hi);
            const f32x4 a0 = *(const LAS f32x4*)(SSQ + qrow * 8), a1 = *(const LAS f32x4*)(SSQ + qrow * 8 + 4);
            const float tot = (a0.x + a0.y) + (a0.z + a0.w) + (a1.x + a1.y) + (a1.z + a1.w);
            const float rstd = rsqrtf(tot * (1.0f / AW) + EPS);
            bf16_t* op = HEADS + (size_t)(rowq0 + qrow) * D + h * 64 + r32;
            op[0] = (bf16_t)(cvt_pk_bf16(o[0][r] * rstd, 0.f) & 0xffffu);
            op[32] = (bf16_t)(cvt_pk_bf16(o[1][r] * rstd, 0.f) & 0xffffu);
        }
    }
    __syncthreads();
}

constexpr int SSM_WAVE_BYTES = 12800, BU_PITCH = 132, HS_PITCH = 136;
constexpr int SSM_BB_OFF = 8 * SSM_WAVE_BYTES, SSM_CM_OFF = SSM_BB_OFF + 4096, SSM_AB_OFF = SSM_CM_OFF + 16 * HS_PITCH * 2, SSM_SG_OFF = SSM_AB_OFF + 512;
struct SsmParams { const float *lam_re, *lam_im, *log_dt, *b_re, *b_im, *c_re, *c_im, *d_skip; };
__device__ __forceinline__ void ssm_unit(LAS unsigned char* lds, const bf16_t* PROJ, bf16_t* Z, const SsmParams& sp, int b, int g, int tid) {
    const int lane = tid & 63, wave = __builtin_amdgcn_readfirstlane(tid >> 6), fr = lane & 15, fq = lane >> 4;
    LAS float* BU = (LAS float*)(lds + wave * SSM_WAVE_BYTES);
    LAS bf16_t* HS = (LAS bf16_t*)(lds + wave * SSM_WAVE_BYTES + 8448);
    LAS bf16_t* BB = (LAS bf16_t*)(lds + SSM_BB_OFF);
    LAS bf16_t* CM = (LAS bf16_t*)(lds + SSM_CM_OFF);
    LAS float* AB = (LAS float*)(lds + SSM_AB_OFF);
    LAS float* SG = (LAS float*)(lds + SSM_SG_OFF);
    if (tid < 64) {
        const int p = tid;
        const float dt = expf(sp.log_dt[g]);
        const float lr = sp.lam_re[g * NST + p], li = sp.lam_im[g * NST + p];
        const float mag = expf(lr * dt), ang = li * dt;
        float sn, cs; sincosf(ang, &sn, &cs);
        const float abr = mag * cs, abi = mag * sn;
        const float nr = abr - 1.0f, ni = abi, den = lr * lr + li * li;
        const float f_r = (nr * lr + ni * li) / den, f_i = (ni * lr - nr * li) / den;
        AB[2 * p] = abr; AB[2 * p + 1] = abi;
        const float* br = sp.b_re + (size_t)(g * NST + p) * NCH; const float* bi = sp.b_im + (size_t)(g * NST + p) * NCH;
#pragma unroll
        for (int c = 0; c < NCH; c += 2) {
            const float r0 = f_r * br[c] - f_i * bi[c], i0 = f_r * bi[c] + f_i * br[c];
            const float r1 = f_r * br[c + 1] - f_i * bi[c + 1], i1 = f_r * bi[c + 1] + f_i * br[c + 1];
            *(LAS unsigned*)(BB + (2 * p) * NCH + c) = cvt_pk_bf16(r0, r1);
            *(LAS unsigned*)(BB + (2 * p + 1) * NCH + c) = cvt_pk_bf16(i0, i1);
        }
    }
    for (int e = tid; e < NCH * 128; e += 512) {
        const int c = e >> 7, k = e & 127, p = k >> 1;
        const float v = (k & 1) ? -sp.c_im[(size_t)(g * NCH + c) * NST + p] : sp.c_re[(size_t)(g * NCH + c) * NST + p];
        CM[c * HS_PITCH + k] = (bf16_t)(cvt_pk_bf16(v, 0.f) & 0xffffu);
    }
    __syncthreads();
    bf16x8 bbf[8], cmf[4];
#pragma unroll
    for (int t = 0; t < 8; ++t) { bbf[t] = (bf16x8){0, 0, 0, 0, 0, 0, 0, 0}; if (fq < 2) bbf[t] = *(const LAS bf16x8*)(BB + (16 * t + fr) * NCH + 8 * fq); }
#pragma unroll
    for (int s = 0; s < 4; ++s) cmf[s] = *(const LAS bf16x8*)(CM + fr * HS_PITCH + 32 * s + 8 * fq);
    const float dsk = sp.d_skip[g * NCH + fr];
    const float ar = AB[2 * lane], ai = AB[2 * lane + 1];
    const size_t row0 = (size_t)b * SEQ + wave * 512;
    const bf16_t* ubase = PROJ + row0 * INW + 768 + g * NCH;
#define SSM_LDUF(ch_) ((fq < 2) ? *(const bf16x8*)(ubase + (size_t)((ch_) * 16 + fr) * INW + 8 * fq) : (bf16x8){0, 0, 0, 0, 0, 0, 0, 0})
#define SSM_BU_STAGE(UF) do { f32x4 d_[8]; \
        _Pragma("unroll") for (int t = 0; t < 8; ++t) d_[t] = __builtin_amdgcn_mfma_f32_16x16x32_bf16(bbf[t], UF, (f32x4){0.f, 0.f, 0.f, 0.f}, 0, 0, 0); \
        _Pragma("unroll") for (int t = 0; t < 8; ++t) *(LAS f32x4*)(BU + fr * BU_PITCH + 16 * t + 4 * fq) = d_[t]; } while (0)
    float hr = 0.f, hi_ = 0.f;
    {
        bf16x8 ufB = SSM_LDUF(1);
        { const bf16x8 ufA = SSM_LDUF(0); SSM_BU_STAGE(ufA); }
        for (int ch = 0; ch < 32; ++ch) {
            f32x2 bu[16];
#pragma unroll
            for (int tau = 0; tau < 16; ++tau) bu[tau] = *(const LAS f32x2*)(BU + tau * BU_PITCH + 2 * lane);
            const bf16x8 ufC = SSM_LDUF(ch + 2 < 32 ? ch + 2 : 31);
            if (ch + 1 < 32) SSM_BU_STAGE(ufB);
#pragma unroll
            for (int tau = 0; tau < 16; ++tau) {
                const float nhr = ar * hr - ai * hi_ + bu[tau].x, nhi = ar * hi_ + ai * hr + bu[tau].y;
                hr = nhr; hi_ = nhi;
            }
            ufB = ufC;
        }
    }
    SG[(wave * 64 + lane) * 2] = hr; SG[(wave * 64 + lane) * 2 + 1] = hi_;
    __syncthreads();
    {
        float pr = ar, pi = ai;
#pragma unroll
        for (int s = 0; s < 9; ++s) { const float nr = pr * pr - pi * pi, ni = 2.0f * pr * pi; pr = nr; pi = ni; }
        hr = 0.f; hi_ = 0.f;
        for (int w2 = 0; w2 < wave; ++w2) {
            const float sr = SG[(w2 * 64 + lane) * 2], si = SG[(w2 * 64 + lane) * 2 + 1];
            const float nhr = pr * hr - pi * hi_ + sr, nhi = pr * hi_ + pi * hr + si;
            hr = nhr; hi_ = nhi;
        }
    }
    __builtin_amdgcn_s_barrier();
    {
        bf16x8 ufB = SSM_LDUF(1);
        { const bf16x8 ufA = SSM_LDUF(0); SSM_BU_STAGE(ufA); }
        for (int ch = 0; ch < 32; ++ch) {
            f32x2 bu[16];
#pragma unroll
            for (int tau = 0; tau < 16; ++tau) bu[tau] = *(const LAS f32x2*)(BU + tau * BU_PITCH + 2 * lane);
            const bf16x8 ufC = SSM_LDUF(ch + 2 < 32 ? ch + 2 : 31);
            float uu[4];
#pragma unroll
            for (int r = 0; r < 4; ++r) uu[r] = bf2f(ubase[(size_t)(ch * 16 + 4 * fq + r) * INW + fr]);
            if (ch + 1 < 32) SSM_BU_STAGE(ufB);
#pragma unroll
            for (int tau = 0; tau < 16; ++tau) {
                const float nhr = ar * hr - ai * hi_ + bu[tau].x, nhi = ar * hi_ + ai * hr + bu[tau].y;
                hr = nhr; hi_ = nhi;
                *(LAS unsigned*)(HS + tau * HS_PITCH + 2 * lane) = cvt_pk_bf16(hr, hi_);
            }
            f32x4 y = (f32x4){0.f, 0.f, 0.f, 0.f};
#pragma unroll
            for (int s2 = 0; s2 < 4; ++s2) {
                const bf16x8 hf = *(const LAS bf16x8*)(HS + fr * HS_PITCH + 32 * s2 + 8 * fq);
                y = __builtin_amdgcn_mfma_f32_16x16x32_bf16(hf, cmf[s2], y, 0, 0, 0);
            }
#pragma unroll
            for (int r = 0; r < 4; ++r) {
                const float yy = y[r] + dsk * uu[r];
                const float inner = 0.7978845608028654f * (yy + 0.044715f * yy * yy * yy);
                const float zz = yy * __builtin_amdgcn_rcpf(1.0f + fast_exp2(-2.0f * LOG2E * inner));
                Z[(row0 + ch * 16 + 4 * fq + r) * SW + g * NCH + fr] = (bf16_t)(cvt_pk_bf16(zz, 0.f) & 0xffffu);
            }
            ufB = ufC;
        }
    }
#undef SSM_LDUF
#undef SSM_BU_STAGE
    __syncthreads();
}

constexpr int N_PHASES = 2 + 9 * DEPTH;
__global__ void __launch_bounds__(512, 2) fwd_kernel(Args a) {
    extern __shared__ __attribute__((aligned(16))) unsigned char lds_raw[];
    LAS unsigned char* lds = (LAS unsigned char*)lds_raw;
    const int G = gridDim.x;
    volatile LAS unsigned* MISC = (volatile LAS unsigned*)(lds + MISC_OFF);
    if (threadIdx.x < 64) MISC[threadIdx.x] = 0u;
    __syncthreads();
    unsigned* ctl = (unsigned*)(AWS() + WS_CTL);
    XcdBarrier bar; bar.bar = ctl + CW_BAR; bar.x = 0; bar.st = nullptr;
    const int ph_lo = karg_i(0), ph_hi = karg_i(1);
    const bool multi_phase = (ph_hi - ph_lo) > 1;
    if (multi_phase) bar = xcd_barrier_post(ctl + CW_BAR, MISC + 8);
    const int NGW = G * 8;
    float* mod = (float*)(AWS() + WS_MOD);
    bf16_t* XN = (bf16_t*)(AWS() + WS_XN); bf16_t* FM = (bf16_t*)(AWS() + WS_FM); bf16_t* HB = (bf16_t*)(AWS() + WS_H);
    bf16_t* PROJ = (bf16_t*)(AWS() + WS_PROJ); bf16_t* HEADS = (bf16_t*)(AWS() + WS_HEADS); bf16_t* ZB = (bf16_t*)(AWS() + WS_Z);

    for (int ph = ph_lo; ph < ph_hi; ++ph) {
        int tid = threadIdx.x; asm volatile("" : "+v"(tid));
        const int lane = tid & 63, wave = __builtin_amdgcn_readfirstlane(tid >> 6);
        const int gw = blockIdx.x * 8 + wave;
        if (ph == 0) {
#if !defined(NO_P0)
            phase_p0(lds, tid, lane, wave, G);
#endif
        } else if (ph == 1) {
            thin_resid(nullptr, AIN(I_X), nullptr, nullptr, nullptr, AIN(I_PREMIXG), mod + 1 * D, mod + 0 * D, XN, gw, NGW, lane);
        } else {
            const int l = (ph - 2) / 9, sp = (ph - 2) % 9;
            const float* modl = mod + (size_t)l * NB * NMODC;
            if (sp == 0 || sp == 2 || sp == 4 || sp == 6 || sp == 7) {
                unsigned char* ws = AWS();
                const bf16_t* A; const bf16_t* Bt; int N, K; pg8::EpiGen E; E.Z = nullptr; E.bias = nullptr;
                if (sp == 0)      { A = XN; Bt = (const bf16_t*)(ws + WS_WIN) + (size_t)l * INW * D; N = INW; K = D; E.O = PROJ; E.ldc = INW; E.mode = 0; }
                else if (sp == 2) { A = ZB; Bt = (const bf16_t*)(ws + WS_WGLU) + (size_t)l * SW * SW; N = SW; K = SW; E.O = HEADS + AW; E.ldc = D; E.mode = 2; E.Z = ZB; E.bias = AIN(I_BGLU) + (size_t)l * SW; }
                else if (sp == 4) { A = HEADS; Bt = (const bf16_t*)(ws + WS_WOUT) + (size_t)l * D * D; N = D; K = D; E.O = FM; E.ldc = D; E.mode = 0; }
                else if (sp == 6) { A = XN; Bt = (const bf16_t*)(ws + WS_WMI) + (size_t)l * FF * D; N = FF; K = D; E.O = HB; E.ldc = FF; E.mode = 1; }
                else              { A = HB; Bt = (const bf16_t*)(ws + WS_WMO) + (size_t)l * D * FF; N = D; K = FF; E.O = FM; E.ldc = D; E.mode = 0; }
                gemm_call(lds, A, Bt, N, K, E, tid);
            } else if (sp == 1) {
                for (int u = blockIdx.x; u < NB * (SEQ / 128); u += G) {
#if !defined(NO_ATTN)
                    attn_unit(lds, PROJ, HEADS, AIN(I_SINKS) + l * NQH, u / (SEQ / 128), u % (SEQ / 128), tid);
#endif
                }
                SsmParams spp;
                spp.lam_re = AIN(I_LAMRE) + (size_t)l * NGRP * NST; spp.lam_im = AIN(I_LAMIM) + (size_t)l * NGRP * NST; spp.log_dt = AIN(I_LOGDT) + (size_t)l * NGRP;
                spp.b_re = AIN(I_BRE) + (size_t)l * NGRP * NST * NCH; spp.b_im = AIN(I_BIM) + (size_t)l * NGRP * NST * NCH;
                spp.c_re = AIN(I_CRE) + (size_t)l * NGRP * NCH * NST; spp.c_im = AIN(I_CIM) + (size_t)l * NGRP * NCH * NST; spp.d_skip = AIN(I_DSKIP) + (size_t)l * SW;
                for (int u = blockIdx.x; u < NB * NGRP; u += G) {
#if !defined(NO_SSM)
                    ssm_unit(lds, PROJ, ZB, spp, u / NGRP, u % NGRP, tid);
#endif
                }
            } else if (sp == 3) {
                thin_ssm_norm(HEADS, gw, NGW, lane);
            } else if (sp == 5) {
                thin_resid(FM, l == 0 ? AIN(I_X) : AOUT(), AOUT(), modl + 2 * D, AIN(I_POSTMIXG) + (size_t)l * D,
                           AIN(I_PREMLPG) + (size_t)l * D, modl + 4 * D, modl + 3 * D, XN, gw, NGW, lane);
            } else {
                const bool lastl = (l == DEPTH - 1);
                thin_resid(FM, AOUT(), AOUT(), modl + 5 * D, AIN(I_POSTMLPG) + (size_t)l * D,
                           AIN(I_PREMIXG) + (size_t)(lastl ? l : l + 1) * D, modl + (lastl ? 0 : NB * NMODC) + 1 * D, modl + (lastl ? 0 : NB * NMODC) + 0 * D,
                           lastl ? nullptr : XN, gw, NGW, lane);
            }
        }
        if (ph + 1 < ph_hi) {
            if (ph == ph_lo) { asm volatile("s_waitcnt vmcnt(0)" ::: "memory"); __threadfence(); cg::this_grid().sync(); }
            else xcd_barrier(bar);
        }
    }
}

extern "C" void kernel_launch(void* const* d_in, const int* in_sizes, int n_in, void* d_out, int out_size, void* d_ws, size_t ws_size, hipStream_t stream) {
    static int grid = 0;
    if (grid == 0) {
        if (n_in != 25 || out_size != M * D || ws_size < WS_END) { fprintf(stderr, "kernel_launch: unexpected shapes (n_in %d out %d ws %zu)\n", n_in, out_size, ws_size); grid = -1; return; }
        int dev = 0, cus = 0, per_cu = 0;
        hipGetDevice(&dev); hipDeviceGetAttribute(&cus, hipDeviceAttributeMultiprocessorCount, dev);
        if (hipFuncSetAttribute((const void*)fwd_kernel, hipFuncAttributeMaxDynamicSharedMemorySize, LDS_BYTES) != hipSuccess) { fprintf(stderr, "kernel_launch: hipFuncSetAttribute failed\n"); grid = -1; return; }
        hipOccupancyMaxActiveBlocksPerMultiprocessor(&per_cu, (const void*)fwd_kernel, 512, LDS_BYTES);
        (void)hipGetLastError();
        if (per_cu < 1) per_cu = 1;
        grid = cus;
    }
    if (grid < 0) return;
    hipMemsetAsync((char*)d_ws + WS_CTL, 0, CTL_ZERO_BYTES, stream);
    Args a{};
    for (int i = 0; i < 25; ++i) a.in[i] = (const float*)d_in[i];
    a.out = (float*)d_out; a.ws = (unsigned char*)d_ws;
#if MK_MULTI
    for (int ph = 0; ph < N_PHASES; ++ph) {
        a.ph_lo = ph; a.ph_hi = ph + 1;
        hipLaunchKernelGGL(fwd_kernel, dim3(grid), dim3(512), LDS_BYTES, stream, a);
    }
#else
    a.ph_lo = 0; a.ph_hi = N_PHASES;
    void* args[] = {&a};
    hipError_t e = hipLaunchCooperativeKernel((const void*)fwd_kernel, dim3(grid), dim3(512), args, LDS_BYTES, stream);
    if (e != hipSuccess) fprintf(stderr, "cooperative launch failed: %s (grid %d)\n", hipGetErrorString(e), grid);
#endif
}
```
